# Optimizing an MI355X kernel written in HIP

```python
import math
import numpy as np
import jax
import jax.numpy as jnp
from jax import lax

D_MODEL = 1024
BATCH = 16
SEQ = 2048
DEPTH = 2

CTX_LEN = 256
GRID_W = 64
HEAD_DIM = 64
ROPE_HALF = HEAD_DIM // 2
ROPE_THETA = 10000.0
A_HEADS = 8
A_KV_HEADS = 2
B_HEADS = 4
C_HEADS = 16
C_KV_HEADS = 4
WINDOW = 128
Q_BLOCK = 128
D_FF = 2816
N_SUB = 3
HALF_STEP = 0.5
EPS = 1e-6
N_EVEN = (DEPTH + 1) // 2
N_ODD = DEPTH // 2
AB_WIDTHS = (A_HEADS * HEAD_DIM, A_KV_HEADS * HEAD_DIM, A_KV_HEADS * HEAD_DIM,
             B_HEADS * 2 * HEAD_DIM, B_HEADS * 2 * HEAD_DIM, B_HEADS * 2 * HEAD_DIM)
AB_IN = sum(AB_WIDTHS)
AB_OUT = A_HEADS * HEAD_DIM + B_HEADS * 2 * HEAD_DIM
C_WIDTHS = (C_HEADS * HEAD_DIM, C_KV_HEADS * HEAD_DIM, C_KV_HEADS * HEAD_DIM)
C_IN = sum(C_WIDTHS)
C_OUT = C_HEADS * HEAD_DIM

kernel_name = 'hybrid_dit_gqa_diffattn_swa_macaron'


def _rms(x, g):
    xf = x.astype(jnp.float32)
    y = xf * lax.rsqrt(jnp.mean(xf * xf, axis=-1, keepdims=True) + EPS)
    return y.astype(x.dtype) * g


def _pre(x, g, shift, scale):
    return _rms(x, g) * (1 + scale) + shift


def _residual(x, y, g_post, gate, res_w):
    return x + res_w * gate * _rms(y, g_post)


def _swiglu(h, wg, wu, wd):
    return (jax.nn.silu(h @ wg) * (h @ wu)) @ wd


def _split(p, widths):
    out, start = [], 0
    for w in widths:
        out.append(p[..., start:start + w])
        start += w
    return out


def _axial_rope(L):
    rows = L // GRID_W
    row = jnp.repeat(jnp.arange(rows, dtype=jnp.float32), GRID_W)
    col = jnp.tile(jnp.arange(GRID_W, dtype=jnp.float32), rows)
    inv = ROPE_THETA ** (-jnp.arange(0, ROPE_HALF, 2, dtype=jnp.float32) / ROPE_HALF)
    ang = jnp.concatenate([row[:, None] * inv, col[:, None] * inv], axis=-1)
    return jnp.cos(ang), jnp.sin(ang)


def _rope(x, cos, sin):
    shape = (1, x.shape[1]) + (1,) * (x.ndim - 3) + (ROPE_HALF,)
    cs, sn = cos.reshape(shape), sin.reshape(shape)
    x1, x2 = x[..., :ROPE_HALF], x[..., ROPE_HALF:]
    return jnp.concatenate([x1 * cs - x2 * sn, x2 * cs + x1 * sn], axis=-1).astype(x.dtype)


def _softmax_with_sink(s, sink):
    sk = sink[None, :, :, None, None]
    m = jnp.maximum(jnp.max(s, axis=-1, keepdims=True), sk)
    p = jnp.exp(s - m)
    return p / (jnp.sum(p, axis=-1, keepdims=True) + jnp.exp(sk - m))


def _gqa_dense(q, k, v, sink=None):
    B, L, H, dh = q.shape
    Hkv = k.shape[2]
    G = H // Hkv
    nb = L // Q_BLOCK
    scale = dh ** -0.5
    qb = q.reshape(B, nb, Q_BLOCK, Hkv, G, dh).swapaxes(0, 1)

    def one(qblk):
        s = jnp.einsum('bqkgd,bskd->bkgqs', qblk, k).astype(jnp.float32) * scale
        if sink is None:
            p = jax.nn.softmax(s, axis=-1)
        else:
            p = _softmax_with_sink(s, sink.reshape(Hkv, G).astype(jnp.float32))
        return jnp.einsum('bkgqs,bskd->bqkgd', p.astype(v.dtype), v)

    o = lax.map(one, qb)
    return o.swapaxes(0, 1).reshape(B, L, H * dh)


def _diff_attn(q, k, v, lam, sub_gain, lam_init):
    B, L, H, _, dh = q.shape
    nb = L // Q_BLOCK
    scale = dh ** -0.5
    qb = q.reshape(B, nb, Q_BLOCK, H, 2, dh).swapaxes(0, 1)

    def one(qblk):
        s = jnp.einsum('bqhcd,bshcd->bhcqs', qblk, k).astype(jnp.float32) * scale
        p = jax.nn.softmax(s, axis=-1)
        a = p[:, :, 0] - lam * p[:, :, 1]
        return jnp.einsum('bhqs,bshe->bqhe', a.astype(v.dtype), v)

    o = lax.map(one, qb).swapaxes(0, 1).reshape(B, L, H, 2 * dh)
    o = _rms(o, sub_gain) * (1.0 - lam_init)
    return o.reshape(B, L, H * 2 * dh)


def _window_attn(q, k, v, k_ctx, v_ctx, sink):
    B, L, H, dh = q.shape
    Hkv = k.shape[2]
    G = H // Hkv
    C = k_ctx.shape[1]
    nb = L // Q_BLOCK
    band = Q_BLOCK + 2 * WINDOW
    scale = dh ** -0.5
    pad = ((0, 0), (WINDOW, WINDOW), (0, 0), (0, 0))
    k_pad, v_pad = jnp.pad(k, pad), jnp.pad(v, pad)
    sk = sink.reshape(Hkv, G).astype(jnp.float32)

    def one(blk):
        start = blk * Q_BLOCK
        qblk = lax.dynamic_slice_in_dim(q, start, Q_BLOCK, axis=1).reshape(B, Q_BLOCK, Hkv, G, dh)
        kb = lax.dynamic_slice_in_dim(k_pad, start, band, axis=1)
        vb = lax.dynamic_slice_in_dim(v_pad, start, band, axis=1)
        qpos = start + jnp.arange(Q_BLOCK)
        kpos = start - WINDOW + jnp.arange(band)
        valid = (jnp.abs(kpos[None, :] - qpos[:, None]) <= WINDOW) & (kpos >= 0) & (kpos < L)
        s_loc = jnp.einsum('bqkgd,bskd->bkgqs', qblk, kb).astype(jnp.float32) * scale
        s_loc = jnp.where(valid, s_loc, -jnp.inf)
        s_ctx = jnp.einsum('bqkgd,bckd->bkgqc', qblk, k_ctx).astype(jnp.float32) * scale
        p = _softmax_with_sink(jnp.concatenate([s_ctx, s_loc], axis=-1), sk)
        o = (jnp.einsum('bkgqc,bckd->bqkgd', p[..., :C].astype(v.dtype), v_ctx)
             + jnp.einsum('bkgqs,bskd->bqkgd', p[..., C:].astype(v.dtype), vb))
        return o.reshape(B, Q_BLOCK, H * dh)

    o = lax.map(one, jnp.arange(nb))
    return o.swapaxes(0, 1).reshape(B, L, H * dh)


def _split_ab(p):
    B, S, _ = p.shape
    aq, ak, av, bq, bk, bv = _split(p, AB_WIDTHS)
    return (aq.reshape(B, S, A_HEADS, HEAD_DIM), ak.reshape(B, S, A_KV_HEADS, HEAD_DIM),
            av.reshape(B, S, A_KV_HEADS, HEAD_DIM), bq.reshape(B, S, B_HEADS, 2, HEAD_DIM),
            bk.reshape(B, S, B_HEADS, 2, HEAD_DIM), bv.reshape(B, S, B_HEADS, 2 * HEAD_DIM))


def _split_c(p):
    B, S, _ = p.shape
    q, k, v = _split(p, C_WIDTHS)
    return (q.reshape(B, S, C_HEADS, HEAD_DIM), k.reshape(B, S, C_KV_HEADS, HEAD_DIM),
            v.reshape(B, S, C_KV_HEADS, HEAD_DIM))


def _mixer_ab(h_lat, h_ctx, w_in, w_out, q_gain, k_gain, lq1, lk1, lq2, lk2, sub_gain, lam_init,
              cos, sin, ctx_out):
    aq_l, ak_l, av_l, bq_l, bk_l, bv_l = _split_ab(h_lat @ w_in)
    aq_c, ak_c, av_c, bq_c, bk_c, bv_c = _split_ab(h_ctx @ w_in)
    aq_l = _rope(_rms(aq_l, q_gain), cos, sin)
    ak_l = _rope(_rms(ak_l, k_gain), cos, sin)
    ak_c = _rms(ak_c, k_gain)
    bq_l = _rope(bq_l, cos, sin)
    bk_l = _rope(bk_l, cos, sin)
    lam = (jnp.exp(jnp.sum(lq1.astype(jnp.float32) * lk1.astype(jnp.float32)))
           - jnp.exp(jnp.sum(lq2.astype(jnp.float32) * lk2.astype(jnp.float32))) + lam_init)
    a_lat = _gqa_dense(aq_l, jnp.concatenate([ak_c, ak_l], axis=1), jnp.concatenate([av_c, av_l], axis=1))
    b_lat = _diff_attn(bq_l, jnp.concatenate([bk_c, bk_l], axis=1), jnp.concatenate([bv_c, bv_l], axis=1),
                       lam, sub_gain, lam_init)
    y_lat = jnp.concatenate([a_lat, b_lat], axis=-1) @ w_out
    y_ctx = None
    if ctx_out:
        a_ctx = _gqa_dense(_rms(aq_c, q_gain), ak_c, av_c)
        b_ctx = _diff_attn(bq_c, bk_c, bv_c, lam, sub_gain, lam_init)
        y_ctx = jnp.concatenate([a_ctx, b_ctx], axis=-1) @ w_out
    return y_lat, y_ctx


def _mixer_c(h_lat, h_ctx, w_in, w_out, sink, cos, sin, ctx_out):
    q_l, k_l, v_l = _split_c(h_lat @ w_in)
    q_c, k_c, v_c = _split_c(h_ctx @ w_in)
    q_l = _rope(q_l, cos, sin)
    k_l = _rope(k_l, cos, sin)
    y_lat = _window_attn(q_l, k_l, v_l, k_c, v_c, sink) @ w_out
    y_ctx = None
    if ctx_out:
        y_ctx = _gqa_dense(q_c, k_c, v_c, sink) @ w_out
    return y_lat, y_ctx


def setup_inputs(seed: int = 0) -> dict:
    key = jax.random.key(seed)
    ks = jax.random.split(key, 23)
    f32 = jnp.float32

    def nrm(k, shape, scale):
        return jax.random.normal(k, shape, f32) * scale

    def gain(k, shape):
        return 1.0 + nrm(k, shape, 0.02)

    D = D_MODEL
    return {
        'x': nrm(ks[0], (BATCH, SEQ, D), 1.0),
        'c': nrm(ks[1], (BATCH, D), 1.0),
        'ctx': nrm(ks[2], (BATCH, CTX_LEN, D), 1.0),
        'c_ctx': nrm(ks[3], (D,), 1.0),
        'w_mod': nrm(ks[4], (DEPTH, D, N_SUB * 3 * D), 0.5 * D ** -0.5),
        'b_mod': nrm(ks[5], (DEPTH, N_SUB * 3 * D), 0.02),
        'g_pre': gain(ks[6], (DEPTH, N_SUB, D)),
        'g_post': gain(ks[7], (DEPTH, N_SUB, D)),
        'w_ffn_gate': nrm(ks[8], (DEPTH, 2, D, D_FF), D ** -0.5),
        'w_ffn_up': nrm(ks[9], (DEPTH, 2, D, D_FF), D ** -0.5),
        'w_ffn_down': nrm(ks[10], (DEPTH, 2, D_FF, D), D_FF ** -0.5),
        'w_in_ab': nrm(ks[11], (N_EVEN, D, AB_IN), D ** -0.5),
        'w_out_ab': nrm(ks[12], (N_EVEN, AB_OUT, D), AB_OUT ** -0.5),
        'q_gain_a': gain(ks[13], (N_EVEN, HEAD_DIM)),
        'k_gain_a': gain(ks[14], (N_EVEN, HEAD_DIM)),
        'lam_q1': nrm(ks[15], (N_EVEN, HEAD_DIM), 0.1),
        'lam_k1': nrm(ks[16], (N_EVEN, HEAD_DIM), 0.1),
        'lam_q2': nrm(ks[17], (N_EVEN, HEAD_DIM), 0.1),
        'lam_k2': nrm(ks[18], (N_EVEN, HEAD_DIM), 0.1),
        'sub_gain_b': gain(ks[19], (N_EVEN, 2 * HEAD_DIM)),
        'w_in_c': nrm(ks[20], (N_ODD, D, C_IN), D ** -0.5),
        'w_out_c': nrm(ks[21], (N_ODD, C_OUT, D), C_OUT ** -0.5),
        'sink_c': nrm(ks[22], (N_ODD, C_HEADS), 0.5),
    }


def reference(x, c, ctx, c_ctx, w_mod, b_mod, g_pre, g_post, w_ffn_gate, w_ffn_up, w_ffn_down,
              w_in_ab, w_out_ab, q_gain_a, k_gain_a, lam_q1, lam_k1, lam_q2, lam_k2, sub_gain_b,
              w_in_c, w_out_c, sink_c):
    B, L, D = x.shape
    cos, sin = _axial_rope(L)
    x_lat, x_ctx = x, ctx
    for i in range(DEPTH):
        last = i == DEPTH - 1
        mod_l = (jax.nn.silu(c) @ w_mod[i] + b_mod[i]).reshape(B, N_SUB, 3, 1, D)
        mod_c = (jax.nn.silu(c_ctx) @ w_mod[i] + b_mod[i]).reshape(N_SUB, 3, D)

        wg, wu, wd = w_ffn_gate[i, 0], w_ffn_up[i, 0], w_ffn_down[i, 0]
        x_lat = _residual(x_lat, _swiglu(_pre(x_lat, g_pre[i, 0], mod_l[:, 0, 0], mod_l[:, 0, 1]), wg, wu, wd),
                          g_post[i, 0], mod_l[:, 0, 2], HALF_STEP)
        x_ctx = _residual(x_ctx, _swiglu(_pre(x_ctx, g_pre[i, 0], mod_c[0, 0], mod_c[0, 1]), wg, wu, wd),
                          g_post[i, 0], mod_c[0, 2], HALF_STEP)

        h_lat = _pre(x_lat, g_pre[i, 1], mod_l[:, 1, 0], mod_l[:, 1, 1])
        h_ctx = _pre(x_ctx, g_pre[i, 1], mod_c[1, 0], mod_c[1, 1])
        if i % 2 == 0:
            e = i // 2
            lam_init = 0.8 - 0.6 * math.exp(-0.3 * i)
            y_lat, y_ctx = _mixer_ab(h_lat, h_ctx, w_in_ab[e], w_out_ab[e], q_gain_a[e], k_gain_a[e],
                                     lam_q1[e], lam_k1[e], lam_q2[e], lam_k2[e], sub_gain_b[e], lam_init,
                                     cos, sin, not last)
        else:
            o = i // 2
            y_lat, y_ctx = _mixer_c(h_lat, h_ctx, w_in_c[o], w_out_c[o], sink_c[o], cos, sin, not last)
        x_lat = _residual(x_lat, y_lat, g_post[i, 1], mod_l[:, 1, 2], 1.0)
        if not last:
            x_ctx = _residual(x_ctx, y_ctx, g_post[i, 1], mod_c[1, 2], 1.0)

        wg, wu, wd = w_ffn_gate[i, 1], w_ffn_up[i, 1], w_ffn_down[i, 1]
        x_lat = _residual(x_lat, _swiglu(_pre(x_lat, g_pre[i, 2], mod_l[:, 2, 0], mod_l[:, 2, 1]), wg, wu, wd),
                          g_post[i, 2], mod_l[:, 2, 2], HALF_STEP)
        if not last:
            x_ctx = _residual(x_ctx, _swiglu(_pre(x_ctx, g_pre[i, 2], mod_c[2, 0], mod_c[2, 1]), wg, wu, wd),
                              g_post[i, 2], mod_c[2, 2], HALF_STEP)
    return x_lat
```

```cpp
#include <hip/hip_runtime.h>
#include <hip/hip_cooperative_groups.h>
#include <cstdio>
#include <cstdint>
namespace cg = cooperative_groups;
namespace pg8 {
#define PG8_LAS __attribute__((address_space(3)))
typedef unsigned short bf16_t;
typedef short bf16x8 __attribute__((ext_vector_type(8)));
typedef float f32x4 __attribute__((ext_vector_type(4)));
typedef unsigned u32x4 __attribute__((ext_vector_type(4)));
constexpr int BM = 256, BK = 64, HALF = 128, HTB = HALF * BK * 2  , STAGE_BYTES = 8 * HTB, NXCD = 8, WGM = 4;

__host__ __device__ __forceinline__ int lds_byte(int r, int c) { const int st = (r >> 4) * 2 + (c >> 5), rr = r & 15, cc = c & 31, ob = rr * 64 + cc * 2; return st * 1024 + (ob ^ (((ob >> 9) & 1) << 5)); }
__host__ __device__ __forceinline__ void stage_rc(int b, int& R, int& C) { const int st = b / 1024, sb = b % 1024, swz = sb ^ (((sb >> 9) & 1) << 5); R = (st >> 1) * 16 + swz / 64; C = (st & 1) * 32 + (swz % 64) / 2; }
__host__ __device__ __forceinline__ int perm32(int rho) { const int n = rho >> 4, i = rho & 15; return 8 * (i >> 2) + 4 * n + (i & 3); }

struct Unit { int pm, pn; };
struct Gemm { const bf16_t* A; const bf16_t* Bt; int M, N, K; };

struct StaticOrder {
    int nM, nN, nwg, G, c;
    __host__ __device__ void init(int M, int N, int G_, int c_) { nM = M / BM; nN = N / BM; nwg = nM * nN; G = G_; c = c_; }
    __host__ __device__ bool next(int i, Unit& u) const {
        const long L = (long)i * G + c; if (L >= nwg) return false;
        int wgid = (int)L; { const int q = nwg / NXCD, r = nwg % NXCD, xcd = wgid % NXCD, off = wgid / NXCD; wgid = (xcd < r ? xcd * (q + 1) : r * (q + 1) + (xcd - r) * q) + off; }
        const int nig = WGM * nN, gid = wgid / nig, fm = gid * WGM, gsz = (nM - fm) < WGM ? (nM - fm) : WGM;
        u.pm = fm + ((wgid % nig) % gsz); u.pn = (wgid % nig) / gsz; return true;
    }
    __device__ __forceinline__ void a_ready(const Unit&) const {}
    __device__ __forceinline__ void done(const Unit&) const {}
};

__device__ __forceinline__ unsigned cvt_pk_bf16(float lo, float hi) { unsigned r; asm volatile("v_cvt_pk_bf16_f32 %0, %1, %2" : "=v"(r) : "v"(lo), "v"(hi)); return r; }
typedef float f32x2 __attribute__((ext_vector_type(2)));
typedef unsigned u32x2 __attribute__((ext_vector_type(2)));
struct EpiBf16 {
    static constexpr bool PERM = true, AFTER_DRAIN = false;
    bf16_t* O; int ldc;
    __device__ __forceinline__ void operator()(const f32x4 (&acc)[2][2][4][2], const Unit& u, int wr, int wc, int fr, int fq) const {
        const int row0 = u.pm * BM + wr * 64 + fr; const int col0 = u.pn * BM + wc * 32 + 8 * fq;
#pragma unroll
        for (int ai = 0; ai < 2; ++ai)
#pragma unroll
            for (int m = 0; m < 4; ++m) { bf16_t* rowp = O + (size_t)(row0 + ai * HALF + m * 16) * ldc + col0;
#pragma unroll
                for (int bj = 0; bj < 2; ++bj) { const f32x4 v0 = acc[ai][bj][m][0], v1 = acc[ai][bj][m][1];
                    u32x4 w; w.x = cvt_pk_bf16(v0[0], v0[1]); w.y = cvt_pk_bf16(v0[2], v0[3]); w.z = cvt_pk_bf16(v1[0], v1[1]); w.w = cvt_pk_bf16(v1[2], v1[3]);
                    *(u32x4*)(rowp + bj * HALF) = w; } }
    }
};
__device__ __forceinline__ float silu_mul(float g, float u) { return g * __builtin_amdgcn_rcpf(1.0f + __builtin_amdgcn_exp2f(-1.4426950408889634f * g)) * u; }
struct EpiSwiGLU {
    static constexpr bool PERM = true, AFTER_DRAIN = false;
    bf16_t* O; int ldc;
    __device__ __forceinline__ void operator()(const f32x4 (&acc)[2][2][4][2], const Unit& u, int wr, int wc, int fr, int fq) const {
        const int row0 = u.pm * BM + wr * 64 + fr; const int col0 = u.pn * HALF + wc * 32 + 8 * fq;
#pragma unroll
        for (int ai = 0; ai < 2; ++ai)
#pragma unroll
            for (int m = 0; m < 4; ++m) { bf16_t* rowp = O + (size_t)(row0 + ai * HALF + m * 16) * ldc + col0;
                const f32x4 g0 = acc[ai][0][m][0], g1 = acc[ai][0][m][1], u0 = acc[ai][1][m][0], u1 = acc[ai][1][m][1];
                u32x4 w; w.x = cvt_pk_bf16(silu_mul(g0[0], u0[0]), silu_mul(g0[1], u0[1])); w.y = cvt_pk_bf16(silu_mul(g0[2], u0[2]), silu_mul(g0[3], u0[3]));
                w.z = cvt_pk_bf16(silu_mul(g1[0], u1[0]), silu_mul(g1[1], u1[1])); w.w = cvt_pk_bf16(silu_mul(g1[2], u1[2]), silu_mul(g1[3], u1[3]));
                *(u32x4*)rowp = w; }
    }
};
struct EpiY {
    static constexpr bool PERM = true, AFTER_DRAIN = false;
    bf16_t* O; int ldc; float* part;
    __device__ __forceinline__ void operator()(const f32x4 (&acc)[2][2][4][2], const Unit& u, int wr, int wc, int fr, int fq) const {
        const int row0 = u.pm * BM + wr * 64 + fr; const int col0 = u.pn * BM + wc * 32 + 8 * fq;
#pragma unroll
        for (int ai = 0; ai < 2; ++ai)
#pragma unroll
            for (int m = 0; m < 4; ++m) { const int row = row0 + ai * HALF + m * 16; bf16_t* rowp = O + (size_t)row * ldc + col0; float s = 0.f;
#pragma unroll
                for (int bj = 0; bj < 2; ++bj) { const f32x4 v0 = acc[ai][bj][m][0], v1 = acc[ai][bj][m][1];
                    s += (v0[0] * v0[0] + v0[1] * v0[1]) + (v0[2] * v0[2] + v0[3] * v0[3]) + (v1[0] * v1[0] + v1[1] * v1[1]) + (v1[2] * v1[2] + v1[3] * v1[3]);
                    u32x4 w; w.x = cvt_pk_bf16(v0[0], v0[1]); w.y = cvt_pk_bf16(v0[2], v0[3]); w.z = cvt_pk_bf16(v1[0], v1[1]); w.w = cvt_pk_bf16(v1[2], v1[3]);
                    *(u32x4*)(rowp + bj * HALF) = w; }
                s += __shfl_xor(s, 16); s += __shfl_xor(s, 32);
                if (fq == 0) part[(size_t)row * 16 + u.pn * 4 + wc] = s; }
    }
};
struct EpiVT {
    static constexpr bool PERM = true, AFTER_DRAIN = false;
    bf16_t* O; int nvr;
    __device__ __forceinline__ void operator()(const f32x4 (&acc)[2][2][4][2], const Unit& u, int wr, int wc, int fr, int fq) const {
        int b, k0; if (u.pn < 128) { b = u.pn >> 3; k0 = 256 + (u.pn & 7) * 256; } else { b = u.pn - 128; k0 = 0; }
        bf16_t* base = O + (size_t)b * nvr * 2304 + k0 + wc * 32 + 8 * fq; const int row0 = u.pm * BM + wr * 64 + fr;
#pragma unroll
        for (int ai = 0; ai < 2; ++ai)
#pragma unroll
            for (int m = 0; m < 4; ++m) { if (nvr == 768 && u.pm == 2 && ai == 1) continue;
                bf16_t* rowp = base + (size_t)(row0 + ai * HALF + m * 16) * 2304;
#pragma unroll
                for (int bj = 0; bj < 2; ++bj) { const f32x4 v0 = acc[ai][bj][m][0], v1 = acc[ai][bj][m][1];
                    u32x4 w; w.x = cvt_pk_bf16(v0[0], v0[1]); w.y = cvt_pk_bf16(v0[2], v0[3]); w.z = cvt_pk_bf16(v1[0], v1[1]); w.w = cvt_pk_bf16(v1[2], v1[3]);
                    *(u32x4*)(rowp + bj * HALF) = w; } }
    }
};

struct EpiQK {
    static constexpr bool PERM = true, AFTER_DRAIN = false;
    bf16_t* O; int ldc; int layer; const float* cs; const float* sn; const float* qgain; const float* kgain; int tlat; float c2;
    __device__ __forceinline__ void operator()(const f32x4 (&acc)[2][2][4][2], const Unit& u, int wr, int wc, int fr, int fq) const {
        const int H = 4 * u.pn + wc;
        if (H >= (layer == 0 ? 26 : 20)) return;
        if (layer == 1 && u.pm >= 128 && H < 16) return;
        bool is_q, do_rms;
        if (layer == 0) { is_q = H < 8 || (H >= 10 && H < 18); do_rms = H < 10; }
        else { is_q = H < 16; do_rms = false; }
        const long gdelta = (layer == 0 && H >= 8) ? (long)(kgain - qgain) : 0l; const float* gain = qgain + gdelta;
        const float sc = is_q ? c2 : 1.0f;
        f32x4 g1[2], g2[2];
#pragma unroll
        for (int n = 0; n < 2; ++n) { if (do_rms) { g1[n] = *(const f32x4*)(gain + 8 * fq + 4 * n); g2[n] = *(const f32x4*)(gain + 32 + 8 * fq + 4 * n); } else { g1[n] = (f32x4){1.f, 1.f, 1.f, 1.f}; g2[n] = g1[n]; } }
        const int row0 = u.pm * BM + wr * 64 + fr; const int col0 = u.pn * BM + wc * 32 + 8 * fq;
#pragma unroll
        for (int ai = 0; ai < 2; ++ai)
#pragma unroll
            for (int m = 0; m < 4; ++m) { const int row = row0 + ai * HALF + m * 16; bf16_t* rowp = O + (size_t)row * ldc + col0;
                f32x4 x1[2] = {acc[ai][0][m][0], acc[ai][0][m][1]}, x2[2] = {acc[ai][1][m][0], acc[ai][1][m][1]};
                if (do_rms) { float s = 0.f;
#pragma unroll
                    for (int n = 0; n < 2; ++n) s += (x1[n][0] * x1[n][0] + x1[n][1] * x1[n][1]) + (x1[n][2] * x1[n][2] + x1[n][3] * x1[n][3]) + (x2[n][0] * x2[n][0] + x2[n][1] * x2[n][1]) + (x2[n][2] * x2[n][2] + x2[n][3] * x2[n][3]);
                    s += __shfl_xor(s, 16); s += __shfl_xor(s, 32);
                    const float rinv = __builtin_amdgcn_rsqf(s * (1.0f / 64.0f) + 1e-6f);
#pragma unroll
                    for (int n = 0; n < 2; ++n) { x1[n] = x1[n] * rinv * g1[n]; x2[n] = x2[n] * rinv * g2[n]; } }
                if (row < tlat) { const int pos = row & 2047;
#pragma unroll
                    for (int n = 0; n < 2; ++n) { const f32x4 c = *(const f32x4*)(cs + pos * 32 + 8 * fq + 4 * n), s = *(const f32x4*)(sn + pos * 32 + 8 * fq + 4 * n);
                        const f32x4 a = x1[n] * c - x2[n] * s, b = x2[n] * c + x1[n] * s; x1[n] = a; x2[n] = b; } }
                u32x4 w1, w2;
                w1.x = cvt_pk_bf16(x1[0][0] * sc, x1[0][1] * sc); w1.y = cvt_pk_bf16(x1[0][2] * sc, x1[0][3] * sc); w1.z = cvt_pk_bf16(x1[1][0] * sc, x1[1][1] * sc); w1.w = cvt_pk_bf16(x1[1][2] * sc, x1[1][3] * sc);
                w2.x = cvt_pk_bf16(x2[0][0] * sc, x2[0][1] * sc); w2.y = cvt_pk_bf16(x2[0][2] * sc, x2[0][3] * sc); w2.z = cvt_pk_bf16(x2[1][0] * sc, x2[1][1] * sc); w2.w = cvt_pk_bf16(x2[1][2] * sc, x2[1][3] * sc);
                *(u32x4*)rowp = w1; *(u32x4*)(rowp + HALF) = w2;
                }
    }
};
template <class Epi, class Sched, bool ALIGN_EPI = false, bool SP2 = false>
__device__ __forceinline__ void gemm_phase(PG8_LAS unsigned char* lds, const Gemm g, const Sched& S, const Epi& E, const int tid_in) {
    const int tid = tid_in, wid = __builtin_amdgcn_readfirstlane(tid >> 6), lane = tid & 63, wr = wid >> 2, wc = wid & 3, fr = lane & 15, fq = lane >> 4;
    const int K = g.K, nt = K / BK;
    unsigned voffA[2], voffB[2];
#pragma unroll
    for (int i = 0; i < 2; ++i) { int R, C; stage_rc(tid * 16 + i * 8192, R, C); const int Rb = Epi::PERM ? ((R & ~31) + perm32(R & 31)) : R;
        voffA[i] = (unsigned)(R * K + C) * 2u; voffB[i] = (unsigned)(Rb * K + C) * 2u; }
    const size_t kstep = (size_t)(BK * 2);
    const size_t hstep = (size_t)HALF * K * 2;
    const size_t tstep = 2 * hstep;
    const unsigned ldsw = (unsigned)wid * 1024u;
    const int aoff = lds_byte(wr * 64 + fr, fq * 8), boff = lds_byte(wc * 32 + fr, fq * 8);
#define PG8_SA(b, h) (((b) * 2 + (h)) * HTB)
#define PG8_SB(b, h) ((4 + (b) * 2 + (h)) * HTB)
#define PG8_STAGE(bufoff, gbase, voff) do { _Pragma("unroll") for (int _i = 0; _i < 2; ++_i) \
        __builtin_amdgcn_global_load_lds((const unsigned*)((const char*)(gbase) + (voff)[_i]), (PG8_LAS unsigned*)(lds + (bufoff) + ldsw + _i * 8192), 16, 0, 0); } while (0)
#define PG8_LDA(dst, b, h) do { _Pragma("unroll") for (int m = 0; m < 4; ++m) _Pragma("unroll") for (int k = 0; k < 2; ++k) dst[m][k] = *(const PG8_LAS bf16x8*)(lds + PG8_SA(b, h) + aoff + m * 2048 + k * 1024); } while (0)
#define PG8_LDB(dst, b, h) do { _Pragma("unroll") for (int n = 0; n < 2; ++n) _Pragma("unroll") for (int k = 0; k < 2; ++k) dst[n][k] = *(const PG8_LAS bf16x8*)(lds + PG8_SB(b, h) + boff + n * 2048 + k * 1024); } while (0)
#define PG8_MMA(ai, bj, At, Bt) do { __builtin_amdgcn_s_setprio(1); _Pragma("unroll") for (int m = 0; m < 4; ++m) _Pragma("unroll") for (int n = 0; n < 2; ++n) _Pragma("unroll") for (int k = 0; k < 2; ++k) \
        acc[ai][bj][m][n] = __builtin_amdgcn_mfma_f32_16x16x32_bf16(Bt[n][k], At[m][k], acc[ai][bj][m][n], 0, 0, 0); __builtin_amdgcn_s_setprio(0); } while (0)
#define PG8_WAIT_V(n) asm volatile("s_waitcnt vmcnt(" #n ")" ::: "memory")
#define PG8_WAIT_L(n) asm volatile("s_waitcnt lgkmcnt(" #n ")" ::: "memory")
#define PG8_BAR __builtin_amdgcn_s_barrier()
#define PG8_SCHED __builtin_amdgcn_sched_barrier(0)
    Unit cur, nxt; int ui = 0;
    if (!S.next(0, cur)) return;
    f32x4 acc[2][2][4][2];
#pragma unroll
    for (int a = 0; a < 2; ++a)
#pragma unroll
        for (int b = 0; b < 2; ++b)
#pragma unroll
            for (int m = 0; m < 4; ++m)
#pragma unroll
                for (int n = 0; n < 2; ++n) acc[a][b][m][n] = (f32x4){0.f, 0.f, 0.f, 0.f};
    bf16x8 At[4][2], B0[2][2], B1[2][2];
    const char* cA = (const char*)g.A + (size_t)cur.pm * tstep; const char* cB = (const char*)g.Bt + (size_t)cur.pn * tstep;
    S.a_ready(cur);
    if constexpr (SP2) {
        PG8_STAGE(PG8_SB(0, 0), cB, voffB); PG8_STAGE(PG8_SB(0, 1), cB + hstep, voffB); PG8_STAGE(PG8_SA(0, 0), cA, voffA); PG8_STAGE(PG8_SA(0, 1), cA + hstep, voffA);
        if (wr == 1) PG8_BAR;
        PG8_WAIT_V(2); PG8_BAR;
        PG8_STAGE(PG8_SB(1, 0), cB + kstep, voffB); PG8_STAGE(PG8_SA(1, 0), cA + kstep, voffA); PG8_STAGE(PG8_SB(1, 1), cB + hstep + kstep, voffB);
        PG8_WAIT_V(6); PG8_BAR;
    } else {
        PG8_STAGE(PG8_SB(0, 0), cB, voffB); PG8_STAGE(PG8_SA(0, 0), cA, voffA); PG8_STAGE(PG8_SB(0, 1), cB + hstep, voffB); PG8_STAGE(PG8_SA(0, 1), cA + hstep, voffA);
        if (wr == 1) PG8_BAR;
        PG8_WAIT_V(4); PG8_BAR;
        PG8_STAGE(PG8_SB(1, 0), cB + kstep, voffB); PG8_STAGE(PG8_SA(1, 0), cA + kstep, voffA); PG8_STAGE(PG8_SB(1, 1), cB + hstep + kstep, voffB);
        PG8_WAIT_V(6); PG8_BAR;
    }
    for (;;) {
        const bool has_next = S.next(ui + 1, nxt);
        const char* nA = has_next ? (const char*)g.A + (size_t)nxt.pm * tstep : cA; const char* nB = has_next ? (const char*)g.Bt + (size_t)nxt.pn * tstep : cB;
        for (int t = 0; t < nt; t += 2) {
            const bool last = (t == nt - 2);
            const char* a1 = cA + (size_t)(t + 1) * kstep;
            const char* a2 = last ? nA : cA + (size_t)(t + 2) * kstep; const char* b2 = last ? nB : cB + (size_t)(t + 2) * kstep;
            const char* a3 = a2 + kstep; const char* b3 = b2 + kstep;
            if (last && has_next) S.a_ready(nxt);
            if constexpr (SP2) {
            PG8_LDB(B0, 0, 0); PG8_LDB(B1, 0, 1); PG8_SCHED; PG8_LDA(At, 0, 0); PG8_STAGE(PG8_SA(1, 1), a1 + hstep, voffA);
            PG8_WAIT_V(8); PG8_WAIT_L(0); PG8_BAR; PG8_MMA(0, 0, At, B0); PG8_MMA(0, 1, At, B1); PG8_BAR; PG8_SCHED;
            PG8_LDA(At, 0, 1); PG8_STAGE(PG8_SB(0, 0), b2, voffB); PG8_STAGE(PG8_SB(0, 1), b2 + hstep, voffB); PG8_STAGE(PG8_SA(0, 0), a2, voffA);
            PG8_WAIT_V(8); PG8_WAIT_L(0); PG8_BAR; PG8_MMA(1, 0, At, B0); PG8_MMA(1, 1, At, B1); PG8_BAR; PG8_SCHED;
            PG8_LDB(B0, 1, 0); PG8_LDB(B1, 1, 1); PG8_SCHED; PG8_LDA(At, 1, 0); PG8_STAGE(PG8_SA(0, 1), a2 + hstep, voffA);
            PG8_WAIT_V(8); PG8_WAIT_L(0); PG8_BAR; PG8_MMA(0, 0, At, B0); PG8_MMA(0, 1, At, B1); PG8_BAR; PG8_SCHED;
            PG8_LDA(At, 1, 1); PG8_STAGE(PG8_SB(1, 0), b3, voffB); PG8_STAGE(PG8_SB(1, 1), b3 + hstep, voffB); PG8_STAGE(PG8_SA(1, 0), a3, voffA);
            PG8_WAIT_V(8); PG8_WAIT_L(0); PG8_BAR; PG8_MMA(1, 0, At, B0); PG8_MMA(1, 1, At, B1); PG8_BAR; PG8_SCHED;
            } else {
            PG8_LDB(B0, 0, 0); PG8_SCHED; PG8_LDA(At, 0, 0); PG8_STAGE(PG8_SA(1, 1), a1 + hstep, voffA);
            PG8_WAIT_L(8); PG8_BAR; PG8_WAIT_L(0); PG8_MMA(0, 0, At, B0); PG8_BAR; PG8_SCHED;
            PG8_LDB(B1, 0, 1); PG8_STAGE(PG8_SB(0, 0), b2, voffB);
            PG8_BAR; PG8_WAIT_L(0); PG8_MMA(0, 1, At, B1); PG8_BAR;
            PG8_LDA(At, 0, 1); PG8_STAGE(PG8_SA(0, 0), a2, voffA);
            PG8_BAR; PG8_WAIT_L(0); PG8_MMA(1, 0, At, B0); PG8_BAR; PG8_SCHED;
            PG8_STAGE(PG8_SB(0, 1), b2 + hstep, voffB);
            PG8_WAIT_V(6); PG8_BAR; PG8_MMA(1, 1, At, B1); PG8_BAR;
            PG8_LDB(B0, 1, 0); PG8_SCHED; PG8_LDA(At, 1, 0); PG8_STAGE(PG8_SA(0, 1), a2 + hstep, voffA);
            PG8_WAIT_L(8); PG8_BAR; PG8_WAIT_L(0); PG8_MMA(0, 0, At, B0); PG8_BAR; PG8_SCHED;
            PG8_LDB(B1, 1, 1); PG8_STAGE(PG8_SB(1, 0), b3, voffB);
            PG8_BAR; PG8_WAIT_L(0); PG8_MMA(0, 1, At, B1); PG8_BAR;
            PG8_LDA(At, 1, 1); PG8_STAGE(PG8_SA(1, 0), a3, voffA);
            PG8_BAR; PG8_WAIT_L(0); PG8_MMA(1, 0, At, B0); PG8_BAR; PG8_SCHED;
            PG8_STAGE(PG8_SB(1, 1), b3 + hstep, voffB);
            PG8_WAIT_V(6); PG8_BAR; PG8_MMA(1, 1, At, B1); PG8_BAR;
            }
        }
        if constexpr (ALIGN_EPI) { if (wr == 0) PG8_BAR; }
        if constexpr (!Epi::AFTER_DRAIN) { E(acc, cur, wr, wc, fr, fq); S.done(cur); }
        if (!has_next) break;
#pragma unroll
        for (int a = 0; a < 2; ++a)
#pragma unroll
            for (int b = 0; b < 2; ++b)
#pragma unroll
                for (int m = 0; m < 4; ++m)
#pragma unroll
                    for (int n = 0; n < 2; ++n) acc[a][b][m][n] = (f32x4){0.f, 0.f, 0.f, 0.f};
        cur = nxt; cA = nA; cB = nB; ++ui;
        if constexpr (ALIGN_EPI) { if (wr == 1) PG8_BAR; }
    }
    PG8_WAIT_V(0);
    if constexpr (!ALIGN_EPI) { if (wr == 0) PG8_BAR; }
    PG8_BAR;
    if constexpr (Epi::AFTER_DRAIN) { E.fused(acc, cur, wr, wc, fr, fq, lds, wid, lane); S.done(cur); }
#undef PG8_SA
#undef PG8_SB
#undef PG8_STAGE
#undef PG8_LDA
#undef PG8_LDB
#undef PG8_MMA
#undef PG8_WAIT_V
#undef PG8_WAIT_L
#undef PG8_BAR
#undef PG8_SCHED
}
}

#define LAS __attribute__((address_space(3)))
typedef unsigned short bf16;
typedef float f32x4 __attribute__((ext_vector_type(4)));
typedef float f32x2v __attribute__((ext_vector_type(2)));
typedef float f32x16 __attribute__((ext_vector_type(16)));
typedef short bf16x8 __attribute__((ext_vector_type(8)));
typedef unsigned u32x4 __attribute__((ext_vector_type(4)));
typedef unsigned u32x2 __attribute__((ext_vector_type(2)));

constexpr int D = 1024, NB = 16, SEQ = 2048, CTX = 256, FF = 2816;
constexpr int TLAT = NB * SEQ;
constexpr int TCTX = NB * CTX;
constexpr int T = TLAT + TCTX;
constexpr int NKEY = CTX + SEQ;
constexpr int NMOD = 9 * D;
constexpr int PQK0 = 1792, PQK1 = 1280;
constexpr int NVR0 = 768, NVR1 = 256;
constexpr float EPS = 1e-6f;
constexpr float C2 = 0.125f * 1.4426950408889634f;
constexpr float LOG2E = 1.4426950408889634f;

constexpr size_t MiB = 1u << 20;
constexpr size_t WS_MOD = 1 * MiB;
constexpr size_t WS_ROPE = 3 * MiB;
constexpr size_t WS_PART = 4 * MiB;
constexpr size_t WS_XCTX = 7 * MiB;
constexpr size_t WS_WGU = 23 * MiB;
constexpr size_t WGU_BYTES = (size_t)2 * FF * D * 2;
constexpr size_t WS_WD = 67 * MiB;
constexpr size_t WD_BYTES = (size_t)D * FF * 2;
constexpr size_t WS_WQK0 = 89 * MiB;
constexpr size_t WS_WV0 = WS_WQK0 + (size_t)1792 * 1024 * 2;
constexpr size_t WS_WOUT0 = 94 * MiB;
constexpr size_t WS_WINC = 96 * MiB;
constexpr size_t WS_WOUTC = 99 * MiB;
constexpr size_t WS_H = 101 * MiB;
constexpr size_t WS_Y = 173 * MiB;
constexpr size_t WS_ACT = 245 * MiB;
constexpr size_t WS_VT = WS_ACT + 126 * MiB;
constexpr size_t WS_END = 443 * MiB;
static_assert(WS_WV0 + (size_t)768 * 1024 * 2 <= WS_WOUT0, "ws map");
static_assert(WS_VT + (size_t)NB * NVR0 * NKEY * 2 <= WS_END && (size_t)T * PQK0 * 2 <= 126 * MiB, "ws map");
static_assert(WS_ACT + (size_t)T * FF * 2 <= WS_END, "ws map");

constexpr int RING_BYTES = 131072, LDS_BYTES = 135168;
constexpr int NWAVES = 8;

struct Args { const float* in[23]; float* out; unsigned char* ws; int ph_lo, ph_hi; };
enum { I_X = 0, I_C, I_CTX, I_CCTX, I_WMOD, I_BMOD, I_GPRE, I_GPOST, I_WG, I_WU, I_WD, I_WINAB, I_WOUTAB, I_QGAIN, I_KGAIN, I_LQ1, I_LK1, I_LQ2, I_LK2, I_SUBG, I_WINC, I_WOUTC, I_SINK };

template <class Tp> __device__ __forceinline__ Tp* as_global(Tp* p) { return (Tp*)(__attribute__((address_space(1))) Tp*)(unsigned long long)p; }
__device__ __forceinline__ float wave_sum(float v) {
#pragma unroll
    for (int o = 1; o < 64; o <<= 1) v += __shfl_xor(v, o);
    return v;
}
__device__ __forceinline__ unsigned f2bf(float f) { unsigned u = __builtin_bit_cast(unsigned, f); return (u + 0x7fffu + ((u >> 16) & 1u)) >> 16; }
__device__ __forceinline__ unsigned pk2(float lo, float hi) { return f2bf(lo) | (f2bf(hi) << 16); }
typedef float f32x2_t __attribute__((ext_vector_type(2))); typedef __bf16 bf16x2_t __attribute__((ext_vector_type(2)));
__device__ __forceinline__ unsigned cvtpk_s(float lo, float hi) { f32x2_t v = {lo, hi}; bf16x2_t b = __builtin_convertvector(v, bf16x2_t); return __builtin_bit_cast(unsigned, b); }
__device__ __forceinline__ float bf_lo(unsigned w) { return __builtin_bit_cast(float, w << 16); }
__device__ __forceinline__ float bf_hi(unsigned w) { return __builtin_bit_cast(float, w & 0xffff0000u); }

__device__ __forceinline__ void transpose_item(const float* W, int K, int N, int k0, int n0, bf16* dst, LAS float* scr, int lane) {
    f32x4 wv[8];
#pragma unroll
    for (int i = 0; i < 8; ++i) wv[i] = __builtin_nontemporal_load((const f32x4*)(W + (size_t)(k0 + 8 * i + (lane >> 3)) * N + n0 + 4 * (lane & 7)));
#pragma unroll
    for (int i = 0; i < 8; ++i) { LAS float* sp = scr + (8 * i + (lane >> 3)) * 33 + 4 * (lane & 7); sp[0] = wv[i][0]; sp[1] = wv[i][1]; sp[2] = wv[i][2]; sp[3] = wv[i][3]; }
    asm volatile("s_waitcnt lgkmcnt(0)" ::: "memory");
    const int c = lane & 7;
#pragma unroll
    for (int j = 0; j < 4; ++j) { const int n = (lane >> 3) + 8 * j; const LAS float* s = scr + (8 * c) * 33 + n;
        u32x4 o; o.x = pk2(s[0 * 33], s[1 * 33]); o.y = pk2(s[2 * 33], s[3 * 33]); o.z = pk2(s[4 * 33], s[5 * 33]); o.w = pk2(s[6 * 33], s[7 * 33]);
        *(u32x4*)(dst + (size_t)n * K + k0 + 8 * c) = o; }
    asm volatile("s_waitcnt lgkmcnt(0)" ::: "memory");
}

__device__ __forceinline__ void prologue(const Args& a, LAS unsigned char* lds, int gw, int NGW, int wave, int lane, int tid, int G) {
    unsigned char* ws = a.ws;
    {
        LAS float* scr = (LAS float*)(lds + wave * 16384);
        constexpr int IT_G = (D / 64) * (FF / 32);
        constexpr int IT_D = (FF / 64) * (D / 32);
        constexpr int IT_AB = (D / 64) * (2304 / 32);
        constexpr int IT_O = (D / 64) * (D / 32);
        constexpr int IT_C = (D / 64) * (1536 / 32);
        constexpr int NITEMS = 8 * IT_G + 4 * IT_D + IT_AB + IT_O + IT_C + IT_O;
        for (int it = gw; it < NITEMS; it += NGW) {
            int r = it;
            if (r < 8 * IT_G) {
                const int mat = r / IT_G, q = r % IT_G, mi = mat >> 1, which = mat & 1;
                const int nblk = FF / 32, kb = q / nblk, nb = q % nblk, n0 = nb * 32;
                const float* W = as_global(a.in[which ? I_WU : I_WG]) + (size_t)mi * D * FF;
                bf16* dst = (bf16*)(ws + WS_WGU + (size_t)mi * WGU_BYTES) + (size_t)((n0 >> 7) * 256 + which * 128 + (n0 & 127)) * D;
                transpose_item(W, D, FF, kb * 64, n0, dst, scr, lane); continue; }
            r -= 8 * IT_G;
            if (r < 4 * IT_D) {
                const int mi = r / IT_D, q = r % IT_D; const int nblk = D / 32, kb = q / nblk, nb = q % nblk, n0 = nb * 32;
                const float* W = as_global(a.in[I_WD]) + (size_t)mi * FF * D;
                bf16* dst = (bf16*)(ws + WS_WD + (size_t)mi * WD_BYTES) + (size_t)n0 * FF;
                transpose_item(W, FF, D, kb * 64, n0, dst, scr, lane); continue; }
            r -= 4 * IT_D;
            if (r < IT_AB) {
                const int nblk = 2304 / 32, kb = r / nblk, nb = r % nblk, n0 = nb * 32;
                bf16* dst;
                if (n0 >= 640 && n0 < 768) dst = (bf16*)(ws + WS_WV0) + (size_t)(n0 - 640) * D;
                else if (n0 >= 1792) dst = (bf16*)(ws + WS_WV0) + (size_t)(128 + n0 - 1792) * D;
                else { const int pc = n0 < 640 ? n0 : n0 - 128, Hh = pc >> 6, dh = (pc >> 5) & 1; dst = (bf16*)(ws + WS_WQK0) + (size_t)(256 * (Hh >> 2) + 128 * dh + 32 * (Hh & 3)) * D; }
                transpose_item(as_global(a.in[I_WINAB]), D, 2304, kb * 64, n0, dst, scr, lane); continue; }
            r -= IT_AB;
            if (r < IT_O) { const int nblk = D / 32, kb = r / nblk, nb = r % nblk, n0 = nb * 32;
                transpose_item(as_global(a.in[I_WOUTAB]), D, D, kb * 64, n0, (bf16*)(ws + WS_WOUT0) + (size_t)n0 * D, scr, lane); continue; }
            r -= IT_O;
            if (r < IT_C) { const int nblk = 1536 / 32, kb = r / nblk, nb = r % nblk, n0 = nb * 32;
                const int Hh = n0 >> 6, dh = (n0 >> 5) & 1; const int drow = n0 < 1280 ? 256 * (Hh >> 2) + 128 * dh + 32 * (Hh & 3) : n0;
                transpose_item(as_global(a.in[I_WINC]), D, 1536, kb * 64, n0, (bf16*)(ws + WS_WINC) + (size_t)drow * D, scr, lane); continue; }
            r -= IT_C;
            { const int nblk = D / 32, kb = r / nblk, nb = r % nblk, n0 = nb * 32;
                transpose_item(as_global(a.in[I_WOUTC]), D, D, kb * 64, n0, (bf16*)(ws + WS_WOUTC) + (size_t)n0 * D, scr, lane); }
        }
    }
    {
        float* cs = (float*)(ws + WS_ROPE); float* sn = cs + SEQ * 32;
        for (int i = blockIdx.x * 512 + tid; i < SEQ * 32; i += G * 512) {
            const int pos = i >> 5, j = i & 31; const float p = (j < 16) ? (float)(pos >> 6) : (float)(pos & 63);
            const float inv = __builtin_amdgcn_exp2f(-(float)(j & 15) * (13.287712379549449f / 16.0f));
            const float ang = p * inv; cs[i] = __cosf(ang); sn[i] = __sinf(ang);
        }
    }
    __syncthreads();
    {
        LAS float* sc = (LAS float*)lds;
        LAS float* red = (LAS float*)(lds + 17 * 1024 * 4);
        for (int i = tid; i < 17 * 1024; i += 512) { const float v = (i < 16 * 1024) ? as_global(a.in[I_C])[i] : as_global(a.in[I_CCTX])[i - 16 * 1024];
            sc[i] = v * __builtin_amdgcn_rcpf(1.0f + __builtin_amdgcn_exp2f(-LOG2E * v)); }
        __syncthreads();
        float* mod = (float*)(ws + WS_MOD);
        for (int it = blockIdx.x; it < 2 * (NMOD / 64); it += G) {
            const int l = it / (NMOD / 64), cg_ = it % (NMOD / 64), col = cg_ * 64 + lane;
            const float* wp = as_global(a.in[I_WMOD]) + (size_t)l * D * NMOD + (size_t)(wave * 128) * NMOD + col;
            float acc[17];
#pragma unroll
            for (int m = 0; m < 17; ++m) acc[m] = 0.f;
            for (int k = 0; k < 128; k += 32) {
                float w[32];
#pragma unroll
                for (int u = 0; u < 32; ++u) w[u] = __builtin_nontemporal_load(wp + (size_t)(k + u) * NMOD);
#pragma unroll
                for (int u = 0; u < 32; ++u)
#pragma unroll
                    for (int m = 0; m < 17; ++m) acc[m] += sc[m * 1024 + wave * 128 + k + u] * w[u];
            }
#pragma unroll
            for (int m = 0; m < 17; ++m) red[(wave * 17 + m) * 64 + lane] = acc[m];
            __syncthreads();
            for (int o = tid; o < 17 * 64; o += 512) { const int m = o >> 6, ln = o & 63; float s = 0.f;
#pragma unroll
                for (int w = 0; w < 8; ++w) s += red[(w * 17 + m) * 64 + ln];
                mod[((size_t)l * 17 + m) * NMOD + cg_ * 64 + ln] = s + as_global(a.in[I_BMOD])[l * NMOD + cg_ * 64 + ln]; }
            __syncthreads();
        }
    }
}

struct ResidParams {
    const float* xsrc_lat; const float* xsrc_ctx;
    float* xdst_lat; float* xdst_ctx;
    const bf16* y; const float* part;
    bf16* h;
    const float* gate; const float* gpost;
    const float* shift; const float* scale; const float* gpre;
    float res_w; int nrows; int has_y, has_h, write_x; int row_lo;
};
__device__ __forceinline__ void resid_pass(const ResidParams& P, int gw, int NGW, int lane) {
    const int nitems = P.nrows >> 2;
    for (int it = gw; it < nitems; it += NGW) {
        const int row0 = P.row_lo + it * 4; const int mi = row0 < TLAT ? (row0 >> 11) : 16;
        f32x4 a1[4], a2[4], a3[4];
#pragma unroll
        for (int j = 0; j < 4; ++j) { const int c = 4 * lane + 256 * j;
            if (P.has_y) { const f32x4 g = *(const f32x4*)(P.gate + (size_t)mi * NMOD + c), gp = *(const f32x4*)(P.gpost + c); a1[j] = g * gp * P.res_w; } else a1[j] = (f32x4){0.f, 0.f, 0.f, 0.f};
            if (P.has_h) { const f32x4 sc = *(const f32x4*)(P.scale + (size_t)mi * NMOD + c), sh = *(const f32x4*)(P.shift + (size_t)mi * NMOD + c), gp = *(const f32x4*)(P.gpre + c);
                a2[j] = gp * (sc + 1.0f); a3[j] = sh; } else { a2[j] = (f32x4){0.f, 0.f, 0.f, 0.f}; a3[j] = a2[j]; } }
#pragma unroll 1
        for (int rp = 0; rp < 4; rp += 2) {
            f32x4 x[2][4]; u32x2 yw[2][4]; float ps[2];
#pragma unroll
            for (int q = 0; q < 2; ++q) { const int row = row0 + rp + q;
                const float* xs = row < TLAT ? P.xsrc_lat + (size_t)row * D : P.xsrc_ctx + (size_t)(row - TLAT) * D;
#pragma unroll
                for (int j = 0; j < 4; ++j) x[q][j] = __builtin_nontemporal_load((const f32x4*)(xs + 4 * lane + 256 * j));
                if (P.has_y) { ps[q] = lane < 16 ? P.part[(size_t)row * 16 + lane] : 0.f;
#pragma unroll
                    for (int j = 0; j < 4; ++j) yw[q][j] = __builtin_nontemporal_load((const u32x2*)(P.y + (size_t)row * D + 4 * lane + 256 * j)); } }
#pragma unroll
            for (int q = 0; q < 2; ++q) { const int row = row0 + rp + q;
                float* xd = row < TLAT ? P.xdst_lat + (size_t)row * D : P.xdst_ctx + (size_t)(row - TLAT) * D;
                if (P.has_y) {
                    const float ss = wave_sum(ps[q]); const float rinv = rsqrtf(ss * (1.0f / D) + EPS);
#pragma unroll
                    for (int j = 0; j < 4; ++j) { const u32x2 w = yw[q][j];
                        const f32x4 yv = (f32x4){bf_lo(w.x), bf_hi(w.x), bf_lo(w.y), bf_hi(w.y)}; x[q][j] = x[q][j] + a1[j] * (yv * rinv); }
                }
                if (P.write_x) {
#pragma unroll
                    for (int j = 0; j < 4; ++j) __builtin_nontemporal_store(x[q][j], (f32x4*)(xd + 4 * lane + 256 * j));
                }
                if (P.has_h) {
                    float s2 = 0.f;
#pragma unroll
                    for (int j = 0; j < 4; ++j) s2 += (x[q][j][0] * x[q][j][0] + x[q][j][1] * x[q][j][1]) + (x[q][j][2] * x[q][j][2] + x[q][j][3] * x[q][j][3]);
                    const float rinv2 = rsqrtf(wave_sum(s2) * (1.0f / D) + EPS);
#pragma unroll
                    for (int j = 0; j < 4; ++j) { const f32x4 hv = (x[q][j] * rinv2) * a2[j] + a3[j]; u32x2 w; w.x = pk2(hv[0], hv[1]); w.y = pk2(hv[2], hv[3]);
                        *(u32x2*)(P.h + (size_t)row * D + 4 * lane + 256 * j) = w; }
                }
            }
        }
    }
}

__device__ __forceinline__ void qk_pass(bf16* Pq, int layer, const float* qgain, const float* kgain, const float* cs, const float* sn, int gw, int NGW, int lane) {
    const int pitch = layer == 0 ? PQK0 : PQK1, nheads = layer == 0 ? 26 : 20, nrows = layer == 0 ? T : TLAT;
    const int hs = lane >> 2, i = lane & 3;
    for (int row = gw; row < nrows; row += NGW) {
        const bool lat = row < TLAT; const int pos = row & (SEQ - 1);
        bf16* rp = Pq + (size_t)row * pitch;
        u32x4 w1[2], w2[2]; f32x4 cva, cvb, sva, svb;
#pragma unroll
        for (int st = 0; st < 2; ++st) { const int head = st * 16 + hs; if (head < nheads) { w1[st] = *(const u32x4*)(rp + head * 64 + 8 * i); w2[st] = *(const u32x4*)(rp + head * 64 + 32 + 8 * i); } }
        if (lat) { cva = *(const f32x4*)(cs + pos * 32 + 8 * i); cvb = *(const f32x4*)(cs + pos * 32 + 8 * i + 4); sva = *(const f32x4*)(sn + pos * 32 + 8 * i); svb = *(const f32x4*)(sn + pos * 32 + 8 * i + 4); }
        else { cva = (f32x4){1.f, 1.f, 1.f, 1.f}; cvb = cva; sva = (f32x4){0.f, 0.f, 0.f, 0.f}; svb = sva; }
        const float cv[8] = {cva[0], cva[1], cva[2], cva[3], cvb[0], cvb[1], cvb[2], cvb[3]}, sv[8] = {sva[0], sva[1], sva[2], sva[3], svb[0], svb[1], svb[2], svb[3]};
#pragma unroll
        for (int st = 0; st < 2; ++st) {
            const int head = st * 16 + hs; if (head >= nheads) continue;
            bool is_q, do_rms, do_rope; const float* gain = qgain;
            if (layer == 0) { is_q = head < 8 || (head >= 10 && head < 18); do_rms = head < 10; gain = head < 8 ? qgain : kgain; do_rope = lat; }
            else { is_q = head < 16; do_rms = false; do_rope = true; }
            if (!lat && !is_q && !do_rms) continue;
            float x1[8], x2[8];
#pragma unroll
            for (int j = 0; j < 4; ++j) { x1[2 * j] = bf_lo(w1[st][j]); x1[2 * j + 1] = bf_hi(w1[st][j]); x2[2 * j] = bf_lo(w2[st][j]); x2[2 * j + 1] = bf_hi(w2[st][j]); }
            if (do_rms) {
                float s = 0.f;
#pragma unroll
                for (int j = 0; j < 8; ++j) s += x1[j] * x1[j] + x2[j] * x2[j];
                s += __shfl_xor(s, 1); s += __shfl_xor(s, 2);
                const float rinv = rsqrtf(s * (1.0f / 64.0f) + EPS);
                const f32x4 ga = *(const f32x4*)(gain + 8 * i), gb = *(const f32x4*)(gain + 8 * i + 4), gc = *(const f32x4*)(gain + 32 + 8 * i), gd = *(const f32x4*)(gain + 32 + 8 * i + 4);
#pragma unroll
                for (int j = 0; j < 4; ++j) { x1[j] *= rinv * ga[j]; x1[4 + j] *= rinv * gb[j]; x2[j] *= rinv * gc[j]; x2[4 + j] *= rinv * gd[j]; }
            }
            const float sc = is_q ? C2 : 1.0f;
            u32x4 o1, o2;
#pragma unroll
            for (int j = 0; j < 4; ++j) {
                float a0 = x1[2 * j], a1 = x1[2 * j + 1], b0 = x2[2 * j], b1 = x2[2 * j + 1];
                if (do_rope) { const float c0 = cv[2 * j], c1 = cv[2 * j + 1], s0 = sv[2 * j], s1 = sv[2 * j + 1];
                    const float ra0 = a0 * c0 - b0 * s0, ra1 = a1 * c1 - b1 * s1, rb0 = b0 * c0 + a0 * s0, rb1 = b1 * c1 + a1 * s1; a0 = ra0; a1 = ra1; b0 = rb0; b1 = rb1; }
                o1[j] = pk2(a0 * sc, a1 * sc); o2[j] = pk2(b0 * sc, b1 * sc);
            }
            *(u32x4*)(rp + head * 64 + 8 * i) = o1; *(u32x4*)(rp + head * 64 + 32 + 8 * i) = o2;
        }
    }
}

namespace att {
constexpr int KROW = 144;
constexpr int KBUF = 64 * KROW;
constexpr int VBUF = 128 * KROW;
constexpr int BUF = KBUF + VBUF;
struct Unit {
    const bf16* Q; int qpitch;
    const bf16* Kctx; const bf16* Klat; int kpitch;
    const bf16* VT;
    bf16* O; int opitch;
    int nctx, lat0, nlat;
    int qpos0;
    float sink2; int has_sink;
};
__device__ __forceinline__ void qk_tile(f32x16& p0, f32x16& p1, const LAS unsigned char* kb, int koff, const bf16x8 (&qf)[4], const f32x16& negm) {
    bf16x8 kf[8];
#pragma unroll
    for (int ds = 0; ds < 4; ++ds) { kf[2 * ds] = *(const LAS bf16x8*)(kb + koff + ds * 32); kf[2 * ds + 1] = *(const LAS bf16x8*)(kb + 32 * KROW + koff + ds * 32); }
    p0 = __builtin_amdgcn_mfma_f32_32x32x16_bf16(kf[0], qf[0], negm, 0, 0, 0);
    p1 = __builtin_amdgcn_mfma_f32_32x32x16_bf16(kf[1], qf[0], negm, 0, 0, 0);
#pragma unroll
    for (int ds = 1; ds < 4; ++ds) {
        p0 = __builtin_amdgcn_mfma_f32_32x32x16_bf16(kf[2 * ds], qf[ds], p0, 0, 0, 0);
        p1 = __builtin_amdgcn_mfma_f32_32x32x16_bf16(kf[2 * ds + 1], qf[ds], p1, 0, 0, 0);
    }
}
template <int NDB, bool PIPE>
__device__ __forceinline__ void softmax_pv(f32x16& p0, f32x16& p1, f32x16& pn0, f32x16& pn1, f32x16 (&o)[NDB], float& mref, float& l, f32x16& negm, bool first, const LAS unsigned char* vb, int voff) {
    bf16x8 vf[8];
#pragma unroll
    for (int i = 0; i < 8; ++i) vf[i] = *(const LAS bf16x8*)(vb + (32 * (i >> 2)) * KROW + voff + ((i >> 1) & 1) * 64 + (i & 1) * 32);
    float mx = __builtin_fmaxf(p0[0], p1[0]), mx2 = __builtin_fmaxf(p0[1], p1[1]);
#pragma unroll
    for (int r = 2; r < 16; r += 2) { mx = __builtin_fmaxf(__builtin_fmaxf(mx, p0[r]), p1[r]); mx2 = __builtin_fmaxf(__builtin_fmaxf(mx2, p0[r + 1]), p1[r + 1]); }
    mx = __builtin_fmaxf(mx, mx2);
    mx = fmaxf(mx, __shfl_xor(mx, 32));
    if (first || __any(mx > 8.0f)) { const float dl = first ? mx : fmaxf(mx, 0.f); mref += dl; const float f = first ? 1.0f : __builtin_amdgcn_exp2f(-dl); l *= f;
#pragma unroll
        for (int r = 0; r < 16; ++r) { p0[r] -= dl; p1[r] -= dl; if (PIPE) { pn0[r] -= dl; pn1[r] -= dl; } negm[r] = -mref; }
#pragma unroll
        for (int db = 0; db < NDB; ++db)
#pragma unroll
            for (int r = 0; r < 16; ++r) o[db][r] *= f; }
    float ls = 0.f;
#pragma unroll
    for (int r = 0; r < 16; ++r) { p0[r] = __builtin_amdgcn_exp2f(p0[r]); p1[r] = __builtin_amdgcn_exp2f(p1[r]); ls += p0[r] + p1[r]; }
    l += ls;
    bf16x8 pf[2][2];
#pragma unroll
    for (int s = 0; s < 2; ++s) {
        u32x4 w0, w1;
        w0.x = cvtpk_s(p0[8 * s + 0], p0[8 * s + 1]); w0.y = cvtpk_s(p0[8 * s + 2], p0[8 * s + 3]); w0.z = cvtpk_s(p0[8 * s + 4], p0[8 * s + 5]); w0.w = cvtpk_s(p0[8 * s + 6], p0[8 * s + 7]);
        w1.x = cvtpk_s(p1[8 * s + 0], p1[8 * s + 1]); w1.y = cvtpk_s(p1[8 * s + 2], p1[8 * s + 3]); w1.z = cvtpk_s(p1[8 * s + 4], p1[8 * s + 5]); w1.w = cvtpk_s(p1[8 * s + 6], p1[8 * s + 7]);
        pf[0][s] = __builtin_bit_cast(bf16x8, w0); pf[1][s] = __builtin_bit_cast(bf16x8, w1);
    }
#pragma unroll
    for (int blk = 0; blk < 2; ++blk)
#pragma unroll
        for (int s = 0; s < 2; ++s)
#pragma unroll
            for (int db = 0; db < NDB; ++db) {
                bf16x8 av; if (db < 2) av = vf[db * 4 + blk * 2 + s]; else av = *(const LAS bf16x8*)(vb + (32 * db) * KROW + voff + blk * 64 + s * 32);
                o[db] = __builtin_amdgcn_mfma_f32_32x32x16_bf16(av, pf[blk][s], o[db], 0, 0, 0);
            }
}
__device__ __forceinline__ void mask_tile(f32x16& p0, f32x16& p1, int kpos0, int qpos, int hi) {
    const unsigned base = (unsigned)(kpos0 + 8 * hi - qpos + 128);
#pragma unroll
    for (int r = 0; r < 16; ++r) { const unsigned t0 = base + (unsigned)(16 * (r >> 3) + (r & 7));
        if (t0 > 256u) p0[r] = -1e30f; if (t0 + 32u > 256u) p1[r] = -1e30f; }
}
constexpr int STASH0 = 57344;
template <int DV, bool WIN, bool DIFF>
__device__ __forceinline__ void unit(LAS unsigned char* lds, const Unit& U, int tid, int wid, int lane, float lam, float post, const float* subg) {
    constexpr int NDB = DV / 32, NVL = DV / 64, VB0 = 2 * KBUF;
    asm volatile("" : "+v"(tid)); lane = tid & 63;
    const int r32 = lane & 31, hi = lane >> 5;
    const int nt = U.nctx + U.nlat;
    const int lrow = tid >> 3, lch = tid & 7;
    const int krow = (r32 & ~12) | ((r32 & 4) << 1) | ((r32 & 8) >> 1);
    const int koff = krow * KROW + hi * 16, voff = r32 * KROW + hi * 16;
    const int qw0 = U.qpos0 + wid * 32, qpos = qw0 + r32;
    const unsigned lkoff = (unsigned)(lrow * U.kpitch + (lch & 3) * 8 + (lch >> 2) * 128) * 2u, lvoff = (unsigned)(lrow * NKEY + lch * 8) * 2u;
    const unsigned lsoff = (unsigned)(lrow * KROW + lch * 16);
    LAS unsigned* stash = (LAS unsigned*)(lds + STASH0 + wid * 8192) + lane;
#pragma unroll 1
    for (int cmap = 0; cmap < (DIFF ? 2 : 1); ++cmap) {
    const int coff = cmap * 32;
    bf16x8 qf[4];
    { const bf16* qp = U.Q + coff + (size_t)(wid * 32 + r32) * U.qpitch + hi * 8;
#pragma unroll
      for (int ds = 0; ds < 4; ++ds) qf[ds] = *(const bf16x8*)(qp + (ds & 1) * 16 + (ds >> 1) * 128); }
    f32x16 o[NDB];
#pragma unroll
    for (int db = 0; db < NDB; ++db)
#pragma unroll
        for (int r = 0; r < 16; ++r) o[db][r] = 0.f;
    float mref = 0.f, l = 0.f; f32x16 negm, p0, p1;
#pragma unroll
    for (int r = 0; r < 16; ++r) negm[r] = 0.f;
    u32x4 kregA, vregA[NVL], kregB, vregB[NVL];
#define ATT_LOAD(KR, VR, t) do { const int t_ = (t); const bf16* kp_ = (t_ < U.nctx ? U.Kctx + (size_t)(t_ * 64) * U.kpitch : U.Klat + (size_t)(U.lat0 + (t_ - U.nctx) * 64) * U.kpitch) + coff; \
        KR = *(const u32x4*)((const char*)kp_ + lkoff); const int kidx_ = t_ < U.nctx ? t_ * 64 : CTX + U.lat0 + (t_ - U.nctx) * 64; const bf16* vp_ = U.VT + kidx_; \
        _Pragma("unroll") for (int v_ = 0; v_ < NVL; ++v_) VR[v_] = *(const u32x4*)((const char*)vp_ + lvoff + (unsigned)(v_ * 64 * NKEY * 2)); } while (0)
#define ATT_STORE(KR, VR, buf) do { *(LAS u32x4*)(lds + (buf) * KBUF + lsoff) = KR; \
        _Pragma("unroll") for (int v_ = 0; v_ < NVL; ++v_) *(LAS u32x4*)(lds + VB0 + (buf) * VBUF + v_ * 64 * KROW + lsoff) = VR[v_]; } while (0)
#define ATT_KPOS(t) (U.lat0 + ((t) - U.nctx) * 64)
#define ATT_SKIP(t) (WIN && (t) >= U.nctx && (ATT_KPOS(t) > qw0 + 31 + 128 || ATT_KPOS(t) + 63 < qw0 - 128))
#define ATT_STEP(KL, VL, KS, VS, tt) do { const int t_s = (tt); \
        if (t_s + 2 < nt) ATT_LOAD(KL, VL, t_s + 2); \
        if (!ATT_SKIP(t_s)) { qk_tile(p0, p1, lds + (t_s & 1) * KBUF, koff, qf, negm); \
            if (WIN) { if (t_s >= U.nctx && !(ATT_KPOS(t_s) >= qw0 - 97 && ATT_KPOS(t_s) + 63 <= qw0 + 128)) mask_tile(p0, p1, ATT_KPOS(t_s), qpos, hi); }     \
            softmax_pv<NDB, false>(p0, p1, p0, p1, o, mref, l, negm, t_s == 0, lds + VB0 + (t_s & 1) * VBUF, voff); } \
        if (t_s + 1 < nt) ATT_STORE(KS, VS, (t_s + 1) & 1); \
        __syncthreads(); } while (0)
    ATT_LOAD(kregA, vregA, 0); ATT_STORE(kregA, vregA, 0);
    if (nt > 1) ATT_LOAD(kregB, vregB, 1);
    __syncthreads();
    for (int t = 0; t < nt; t += 2) {
        ATT_STEP(kregA, vregA, kregB, vregB, t);
        if (t + 1 < nt) ATT_STEP(kregB, vregB, kregA, vregA, t + 1);
    }
#undef ATT_LOAD
#undef ATT_STORE
#undef ATT_KPOS
#undef ATT_SKIP
#undef ATT_STEP
    l += __shfl_xor(l, 32);
    if (U.has_sink) l += __builtin_amdgcn_exp2f(U.sink2 - mref);
    const float inv = __builtin_amdgcn_rcpf(l);
    if (DIFF) {
        if (cmap == 0) {
#pragma unroll
            for (int db = 0; db < NDB; ++db)
#pragma unroll
                for (int k = 0; k < 8; ++k) stash[(db * 8 + k) * 64] = pk2(o[db][2 * k] * inv, o[db][2 * k + 1] * inv);
        } else {
            float ss = 0.f;
#pragma unroll
            for (int db = 0; db < NDB; ++db)
#pragma unroll
                for (int k = 0; k < 8; ++k) { const unsigned w = stash[(db * 8 + k) * 64];
                    o[db][2 * k] = bf_lo(w) - lam * (o[db][2 * k] * inv); o[db][2 * k + 1] = bf_hi(w) - lam * (o[db][2 * k + 1] * inv);
                    ss += o[db][2 * k] * o[db][2 * k] + o[db][2 * k + 1] * o[db][2 * k + 1]; }
            ss += __shfl_xor(ss, 32);
            const float rinv = rsqrtf(ss * (1.0f / 128.0f) + EPS) * post;
            bf16* op = U.O + (size_t)(wid * 32 + r32) * U.opitch + 4 * hi;
#pragma unroll
            for (int db = 0; db < NDB; ++db)
#pragma unroll
                for (int g = 0; g < 4; ++g) { const f32x4 sg = *(const f32x4*)(subg + 32 * db + 8 * g + 4 * hi);
                    u32x2 w; w.x = pk2(o[db][4 * g] * rinv * sg[0], o[db][4 * g + 1] * rinv * sg[1]); w.y = pk2(o[db][4 * g + 2] * rinv * sg[2], o[db][4 * g + 3] * rinv * sg[3]);
                    *(u32x2*)(op + 32 * db + 8 * g) = w; }
        }
    } else {
        bf16* op = U.O + (size_t)(wid * 32 + r32) * U.opitch + 4 * hi;
#pragma unroll
        for (int db = 0; db < NDB; ++db)
#pragma unroll
            for (int g = 0; g < 4; ++g) { u32x2 w; w.x = pk2(o[db][4 * g] * inv, o[db][4 * g + 1] * inv); w.y = pk2(o[db][4 * g + 2] * inv, o[db][4 * g + 3] * inv);
                *(u32x2*)(op + 32 * db + 8 * g) = w; }
    }
    }
}
template <bool WIN>
__device__ __forceinline__ void unit2(LAS unsigned char* lds, const Unit& U, int tid, int wid, int lane) {
    constexpr int NDB = 2, VB0 = 4 * KBUF;
    asm volatile("" : "+v"(tid)); lane = tid & 63;
    const int r32 = lane & 31, hi = lane >> 5;
    const int nt = U.nctx + U.nlat, ns = (nt + 1) >> 1;
    const int lrow = tid >> 3, lch = tid & 7;
    const int krow = (r32 & ~12) | ((r32 & 4) << 1) | ((r32 & 8) >> 1);
    const int koff = krow * KROW + hi * 16, voff = r32 * KROW + hi * 16;
    const int qw0 = U.qpos0 + wid * 32, qpos = qw0 + r32;
    const unsigned lkoff = (unsigned)(lrow * U.kpitch + (lch & 3) * 8 + (lch >> 2) * 128) * 2u, lvoff = (unsigned)(lrow * NKEY + lch * 8) * 2u;
    const unsigned lsoff = (unsigned)(lrow * KROW + lch * 16);
    bf16x8 qf[4];
    { const bf16* qp = U.Q + (size_t)(wid * 32 + r32) * U.qpitch + hi * 8;
#pragma unroll
      for (int ds = 0; ds < 4; ++ds) qf[ds] = *(const bf16x8*)(qp + (ds & 1) * 16 + (ds >> 1) * 128); }
    f32x16 o[NDB];
#pragma unroll
    for (int db = 0; db < NDB; ++db)
#pragma unroll
        for (int r = 0; r < 16; ++r) o[db][r] = 0.f;
    float mref = 0.f, l = 0.f; f32x16 negm, p0, p1;
#pragma unroll
    for (int r = 0; r < 16; ++r) negm[r] = 0.f;
    u32x4 kA[2], vA[2], kB[2], vB[2];
#define U2_LOAD(KR, VR, s) do { _Pragma("unroll") for (int j_ = 0; j_ < 2; ++j_) { const int t_ = 2 * (s) + j_; if (t_ < nt) { \
        const bf16* kp_ = t_ < U.nctx ? U.Kctx + (size_t)(t_ * 64) * U.kpitch : U.Klat + (size_t)(U.lat0 + (t_ - U.nctx) * 64) * U.kpitch; \
        KR[j_] = *(const u32x4*)((const char*)kp_ + lkoff); const int kidx_ = t_ < U.nctx ? t_ * 64 : CTX + U.lat0 + (t_ - U.nctx) * 64; \
        VR[j_] = *(const u32x4*)((const char*)(U.VT + kidx_) + lvoff); } } } while (0)
#define U2_STORE(KR, VR, buf) do { _Pragma("unroll") for (int j_ = 0; j_ < 2; ++j_) { *(LAS u32x4*)(lds + ((buf) * 2 + j_) * KBUF + lsoff) = KR[j_]; *(LAS u32x4*)(lds + VB0 + ((buf) * 2 + j_) * KBUF + lsoff) = VR[j_]; } } while (0)
#define U2_KPOS(t) (U.lat0 + ((t) - U.nctx) * 64)
#define U2_SKIP(t) (WIN && (t) >= U.nctx && (U2_KPOS(t) > qw0 + 31 + 128 || U2_KPOS(t) + 63 < qw0 - 128))
#define U2_STEP(KL, VL, KS, VS, ss) do { const int s_ = (ss); \
        if (s_ + 2 < ns) U2_LOAD(KL, VL, s_ + 2); \
        _Pragma("unroll") for (int j2_ = 0; j2_ < 2; ++j2_) { const int t_s = 2 * s_ + j2_; \
            if (t_s < nt && !U2_SKIP(t_s)) { qk_tile(p0, p1, lds + ((s_ & 1) * 2 + j2_) * KBUF, koff, qf, negm); \
                if (WIN) { if (t_s >= U.nctx && !(U2_KPOS(t_s) >= qw0 - 97 && U2_KPOS(t_s) + 63 <= qw0 + 128)) mask_tile(p0, p1, U2_KPOS(t_s), qpos, hi); } \
                softmax_pv<NDB, false>(p0, p1, p0, p1, o, mref, l, negm, t_s == 0, lds + VB0 + ((s_ & 1) * 2 + j2_) * KBUF, voff); } } \
        if (s_ + 1 < ns) U2_STORE(KS, VS, (s_ + 1) & 1); \
        __syncthreads(); } while (0)
    U2_LOAD(kA, vA, 0); U2_STORE(kA, vA, 0);
    if (ns > 1) U2_LOAD(kB, vB, 1);
    __syncthreads();
    for (int s = 0; s < ns; s += 2) {
        U2_STEP(kA, vA, kB, vB, s);
        if (s + 1 < ns) U2_STEP(kB, vB, kA, vA, s + 1);
    }
#undef U2_LOAD
#undef U2_STORE
#undef U2_KPOS
#undef U2_SKIP
#undef U2_STEP
    l += __shfl_xor(l, 32);
    if (U.has_sink) l += __builtin_amdgcn_exp2f(U.sink2 - mref);
    const float inv = __builtin_amdgcn_rcpf(l);
    bf16* op = U.O + (size_t)(wid * 32 + r32) * U.opitch + 4 * hi;
#pragma unroll
    for (int db = 0; db < NDB; ++db)
#pragma unroll
        for (int g = 0; g < 4; ++g) { u32x2 w; w.x = pk2(o[db][4 * g] * inv, o[db][4 * g + 1] * inv); w.y = pk2(o[db][4 * g + 2] * inv, o[db][4 * g + 3] * inv);
            *(u32x2*)(op + 32 * db + 8 * g) = w; }
}
}

__device__ __forceinline__ void combine_pass(const bf16* OB, bf16* o, const float* lq1, const float* lk1, const float* lq2, const float* lk2, const float* subg, float lam_init, int gw, int NGW, int lane) {
    const float s1 = wave_sum(lq1[lane] * lk1[lane]), s2 = wave_sum(lq2[lane] * lk2[lane]);
    const float lam = __builtin_amdgcn_exp2f(s1 * LOG2E) - __builtin_amdgcn_exp2f(s2 * LOG2E) + lam_init;
    const int h = lane >> 4, e0 = (lane & 15) * 8;
    float g[8];
#pragma unroll
    for (int j = 0; j < 8; ++j) g[j] = subg[e0 + j] * (1.0f - lam_init);
    for (int row = gw; row < T; row += NGW) {
        const u32x4 a = *(const u32x4*)(OB + (size_t)row * D + (2 * h) * 128 + e0), b = *(const u32x4*)(OB + (size_t)row * D + (2 * h + 1) * 128 + e0);
        float d[8];
        d[0] = bf_lo(a.x) - lam * bf_lo(b.x); d[1] = bf_hi(a.x) - lam * bf_hi(b.x); d[2] = bf_lo(a.y) - lam * bf_lo(b.y); d[3] = bf_hi(a.y) - lam * bf_hi(b.y);
        d[4] = bf_lo(a.z) - lam * bf_lo(b.z); d[5] = bf_hi(a.z) - lam * bf_hi(b.z); d[6] = bf_lo(a.w) - lam * bf_lo(b.w); d[7] = bf_hi(a.w) - lam * bf_hi(b.w);
        float s = 0.f;
#pragma unroll
        for (int j = 0; j < 8; ++j) s += d[j] * d[j];
        s += __shfl_xor(s, 1); s += __shfl_xor(s, 2); s += __shfl_xor(s, 4); s += __shfl_xor(s, 8);
        const float rinv = rsqrtf(s * (1.0f / 128.0f) + EPS);
        u32x4 w; w.x = pk2(d[0] * rinv * g[0], d[1] * rinv * g[1]); w.y = pk2(d[2] * rinv * g[2], d[3] * rinv * g[3]); w.z = pk2(d[4] * rinv * g[4], d[5] * rinv * g[5]); w.w = pk2(d[6] * rinv * g[6], d[7] * rinv * g[7]);
        *(u32x4*)(o + (size_t)row * D + 512 + h * 128 + e0) = w;
    }
}

#define XB_TMO      128
#define XB_XCNT(j)  (256  + 64 * (j))
#define XB_XSUB(j)  (1280 + 64 * (j))
#define XB_XGEN(j)  (2304 + 64 * (j))
#define XB_TOP      3328
#define XB_TOPGEN   3392
#define XCD_BAR_WORDS 3456
#define XB_SPIN_CAP (1u << 18)

__device__ __forceinline__ unsigned xb_ld(unsigned* p)              { return __hip_atomic_load(p, __ATOMIC_RELAXED, __HIP_MEMORY_SCOPE_AGENT); }
__device__ __forceinline__ unsigned xb_add(unsigned* p, unsigned v) { return __hip_atomic_fetch_add(p, v, __ATOMIC_RELAXED, __HIP_MEMORY_SCOPE_AGENT); }
__device__ __forceinline__ unsigned xb_xcc_id() { return (unsigned)__builtin_amdgcn_s_getreg((3 << 11) | 20) & 0xFu; }
#define XB_SPIN(cond, bar) do { unsigned _sp = 0; while (cond) { __builtin_amdgcn_s_sleep(1); \
    if ((++_sp & 255u) == 0u) { if (xb_ld(&(bar)[XB_TMO])) break; if (_sp > XB_SPIN_CAP) { atomicAdd(&(bar)[XB_TMO], 1u); break; } } } } while (0)

struct XcdBarrier {
    unsigned* bar; unsigned x;
    volatile LAS unsigned* st;
};

__device__ __forceinline__ XcdBarrier xcd_barrier_post(unsigned* bar, volatile LAS unsigned* st) {
    XcdBarrier b; b.bar = bar; b.x = xb_xcc_id(); b.st = st;
    if (threadIdx.x == 0) (void)xb_add(&bar[XB_XCNT(b.x)], 1u);
    return b;
}
__device__ __forceinline__ void xcd_barrier_complete(unsigned* bar, unsigned x, unsigned& nloc, unsigned& nx) {
    const unsigned G = gridDim.x * gridDim.y * gridDim.z;
    unsigned sum, cnt, mine, sp = 0u;
    for (;;) {
        sum = 0u; cnt = 0u; mine = 0u;
#pragma unroll
        for (unsigned j = 0; j < 16; ++j) { const unsigned c = xb_ld(&bar[XB_XCNT(j)]); sum += c; cnt += (c > 0u) ? 1u : 0u; mine = (j == x) ? c : mine; }
        if (sum == G) break;
        __builtin_amdgcn_s_sleep(1);
        if ((++sp & 255u) == 0u) { if (xb_ld(&bar[XB_TMO])) break; if (sp > XB_SPIN_CAP) { atomicAdd(&bar[XB_TMO], 1u); break; } }
    }
    nloc = mine > 0u ? mine : 1u; nx = cnt > 0u ? cnt : 1u;
}

__device__ __forceinline__ void xcd_barrier(const XcdBarrier& b) {
    asm volatile("s_waitcnt vmcnt(0)" ::: "memory");
    __syncthreads();
    if (threadIdx.x == 0) {
        unsigned* bar = b.bar;
        __builtin_amdgcn_s_waitcnt(0);
        unsigned nloc = b.st[0], nx = b.st[1];
        if (nloc == 0u) { xcd_barrier_complete(bar, b.x, nloc, nx); b.st[0] = nloc; b.st[1] = nx; }
        const unsigned old = xb_add(&bar[XB_XSUB(b.x)], 1u);
        const unsigned gen = old / nloc;
        if (old + 1u == (gen + 1u) * nloc) {
            __builtin_amdgcn_fence(__ATOMIC_RELEASE, "agent");
            asm volatile("s_waitcnt vmcnt(0)" ::: "memory");
            const unsigned og = xb_add(&bar[XB_TOP], 1u);
            const unsigned tg = og / nx;
            if (og + 1u == (tg + 1u) * nx) xb_add(&bar[XB_TOPGEN], 1u);
            else XB_SPIN(xb_ld(&bar[XB_TOPGEN]) == tg, bar);
            __builtin_amdgcn_fence(__ATOMIC_ACQUIRE, "agent");
            xb_add(&bar[XB_XGEN(b.x)], 1u);
            asm volatile("s_waitcnt vmcnt(0)" ::: "memory");
        } else {
            XB_SPIN(xb_ld(&bar[XB_XGEN(b.x)]) == gen, bar);
            __builtin_amdgcn_fence(__ATOMIC_ACQUIRE, "agent");
            asm volatile("s_waitcnt vmcnt(0)" ::: "memory");
        }
    }
    __syncthreads();
}

#define HB(H) (256 * ((H) >> 2) + 32 * ((H) & 3))
constexpr int NPHASE = 26;
__global__ void __launch_bounds__(512, 2) mega(Args args) {
    extern __shared__ __attribute__((aligned(16))) unsigned char lds_raw[];
    LAS unsigned char* lds = (LAS unsigned char*)lds_raw;
    cg::grid_group grid = cg::this_grid();
    if (args.ph_lo < 0) grid.sync();
    volatile LAS unsigned* misc = (volatile LAS unsigned*)(lds + RING_BYTES);
    if (threadIdx.x < 64) misc[threadIdx.x] = 0u;
    __syncthreads();
    XcdBarrier bar = xcd_barrier_post(as_global((unsigned*)args.ws) + 1024, misc + 8);

#ifndef MK_REPMASK
#define MK_REPMASK 0
#endif
#ifdef MK_EXTRA_SYNCS
    for (int i = 0; i < MK_EXTRA_SYNCS; ++i) xcd_barrier(bar);
#endif
    for (int ph = args.ph_lo, rep = 0; ph < args.ph_hi; ) {
        if (ph >= 2 && ((ph - 2) % 12 == 6 || (ph - 2) % 12 == 4)) { ++ph; continue; }
        int tid = threadIdx.x; asm volatile("" : "+v"(tid));
        int bx = blockIdx.x; asm volatile("" : "+s"(bx));
        unsigned char* ws; { unsigned long long wi = (unsigned long long)args.ws; unsigned wlo = __builtin_amdgcn_readfirstlane((unsigned)wi), whi = __builtin_amdgcn_readfirstlane((unsigned)(wi >> 32)); asm volatile("" : "+s"(wlo), "+s"(whi)); wi = ((unsigned long long)whi << 32) | wlo; ws = (unsigned char*)(__attribute__((address_space(1))) unsigned char*)wi; }
        const int lane = tid & 63, wave = __builtin_amdgcn_readfirstlane(tid >> 6);
        const int G = gridDim.x;
        const int gw = bx * NWAVES + wave, NGW = G * NWAVES;
        float* mod = (float*)(ws + WS_MOD);
        const float* cs = (const float*)(ws + WS_ROPE); const float* sn = cs + SEQ * 32;
        float* part = (float*)(ws + WS_PART);
        float* xctx = (float*)(ws + WS_XCTX);
        bf16* hbuf = (bf16*)(ws + WS_H); bf16* ybuf = (bf16*)(ws + WS_Y); bf16* actbuf = (bf16*)(ws + WS_ACT); bf16* vtbuf = (bf16*)(ws + WS_VT);
        if (ph == 0) {
#ifndef NO_PRO
            prologue(args, lds, gw, NGW, wave, lane, tid, G);
#endif
        } else if (ph == 1) {
            ResidParams P; P.xsrc_lat = as_global(args.in[I_X]); P.xsrc_ctx = as_global(args.in[I_CTX]); P.xdst_lat = as_global(args.out); P.xdst_ctx = xctx; P.y = nullptr; P.part = nullptr; P.h = hbuf;
            P.gate = nullptr; P.gpost = nullptr; P.shift = mod; P.scale = mod + 1024; P.gpre = as_global(args.in[I_GPRE]); P.res_w = 0.f; P.nrows = T; P.has_y = 0; P.has_h = 1; P.write_x = 0; P.row_lo = 0;
            resid_pass(P, gw, NGW, lane);
        } else {
            const int L = (ph - 2) / 12, q = (ph - 2) % 12;
            const int Mrows = (L == 1 && q >= 5) ? TLAT : T;
            if (q == 0 || q == 9) {
                const int s = q == 0 ? 0 : 1;
                pg8::Gemm g{hbuf, (const bf16*)(ws + WS_WGU + (size_t)(2 * L + s) * WGU_BYTES), Mrows, 2 * FF, D}; pg8::StaticOrder S; S.init(Mrows, 2 * FF, G, bx);
                pg8::EpiSwiGLU E{actbuf, FF};
                pg8::gemm_phase<pg8::EpiSwiGLU, pg8::StaticOrder, true, true>(lds, g, S, E, tid);
            } else if (q == 1 || q == 7 || q == 10) {
                pg8::Gemm g;
                if (q == 7) g = pg8::Gemm{hbuf, (const bf16*)(ws + (L == 0 ? WS_WOUT0 : WS_WOUTC)), TLAT, D, D};
                else g = pg8::Gemm{actbuf, (const bf16*)(ws + WS_WD + (size_t)(2 * L + (q == 1 ? 0 : 1)) * WD_BYTES), TLAT, D, FF};
                pg8::StaticOrder S; S.init(TLAT, D, G, bx);
                pg8::EpiY E{ybuf, D, part};
                pg8::gemm_phase<pg8::EpiY, pg8::StaticOrder, true, true>(lds, g, S, E, tid);
            } else if (q == 2 || q == 8 || q == 11) {
                const int sub = q == 2 ? 0 : (q == 8 ? 1 : 2);
                const bool fin = (L == 1 && q == 11);
                const int Ln = q == 11 ? L + 1 : L, subn = q == 11 ? 0 : sub + 1;
                ResidParams P; P.xsrc_lat = as_global(args.out); P.xsrc_ctx = xctx; P.xdst_lat = as_global(args.out); P.xdst_ctx = xctx; P.y = ybuf; P.part = part; P.h = hbuf;
                if (L == 0 && q == 2) { P.xsrc_lat = as_global(args.in[I_X]); P.xsrc_ctx = as_global(args.in[I_CTX]); }
                P.gate = mod + (size_t)L * 17 * NMOD + sub * 3072 + 2048; P.gpost = as_global(args.in[I_GPOST]) + (L * 3 + sub) * D;
                P.shift = fin ? mod : mod + (size_t)Ln * 17 * NMOD + subn * 3072; P.scale = P.shift + 1024; P.gpre = fin ? as_global(args.in[I_GPRE]) : as_global(args.in[I_GPRE]) + (Ln * 3 + subn) * D;
                P.res_w = (q == 8) ? 1.0f : 0.5f; P.has_y = 1; P.has_h = fin ? 0 : 1; P.write_x = 1;
                const bool split = (Mrows == T) && G > 64;
                if (!split) { P.row_lo = 0; P.nrows = Mrows; resid_pass(P, gw, NGW, lane); }
                else if (bx >= 64) {
                    P.row_lo = 0; P.nrows = TLAT; resid_pass(P, (bx - 64) * NWAVES + wave, (G - 64) * NWAVES, lane);
                } else {
                    pg8::Gemm g;
                    if (q == 8) g = pg8::Gemm{hbuf + (size_t)TLAT * D, (const bf16*)(ws + (L == 0 ? WS_WOUT0 : WS_WOUTC)), TCTX, D, D};
                    else g = pg8::Gemm{actbuf + (size_t)TLAT * FF, (const bf16*)(ws + WS_WD + (size_t)(2 * L + (q == 2 ? 0 : 1)) * WD_BYTES), TCTX, D, FF};
                    pg8::StaticOrder S; S.init(TCTX, D, 64, bx);
                    pg8::EpiY E{ybuf + (size_t)TLAT * D, D, part + (size_t)TLAT * 16};
                    pg8::gemm_phase<pg8::EpiY, pg8::StaticOrder, true, true>(lds, g, S, E, tid);
                    pg8::Unit u; (void)S.next(0, u);
                    unsigned* cnt = as_global((unsigned*)args.ws) + 8192 + ((L * 3 + (q == 2 ? 0 : (q == 8 ? 1 : 2))) * 16 + u.pm) * 64;
                    asm volatile("s_waitcnt vmcnt(0)" ::: "memory"); __syncthreads();
                    if (threadIdx.x == 0) {
                        __builtin_amdgcn_fence(__ATOMIC_RELEASE, "agent"); asm volatile("s_waitcnt vmcnt(0)" ::: "memory");
                        (void)__hip_atomic_fetch_add(cnt, 1u, __ATOMIC_RELAXED, __HIP_MEMORY_SCOPE_AGENT);
                        unsigned sp = 0; while (__hip_atomic_load(cnt, __ATOMIC_RELAXED, __HIP_MEMORY_SCOPE_AGENT) < 4u && ++sp < (1u << 22)) __builtin_amdgcn_s_sleep(2);
                        __builtin_amdgcn_fence(__ATOMIC_ACQUIRE, "agent"); asm volatile("s_waitcnt vmcnt(0)" ::: "memory");
                    }
                    __syncthreads();
                    int tid3 = threadIdx.x; asm volatile("" : "+v"(tid3));
                    P.row_lo = TLAT + u.pm * 256 + u.pn * 64; P.nrows = 64; if (L == 1) P.write_x = 0;
                    resid_pass(P, wave, NWAVES, tid3 & 63);
                }
            } else if (q == 3) {
                { pg8::Gemm g{hbuf, (const bf16*)(ws + (L == 0 ? WS_WQK0 : WS_WINC)), T, L == 0 ? PQK0 : PQK1, D}; pg8::StaticOrder S; S.init(g.M, g.N, G, bx);
                  pg8::EpiQK E{actbuf, L == 0 ? PQK0 : PQK1, L, cs, sn, as_global(args.in[I_QGAIN]), as_global(args.in[I_KGAIN]), TLAT, C2};
                  pg8::gemm_phase<pg8::EpiQK, pg8::StaticOrder, true, true>(lds, g, S, E, tid); }
                __syncthreads();
                int tidb = threadIdx.x; asm volatile("" : "+v"(tidb));
                { pg8::Gemm g{(const bf16*)(ws + (L == 0 ? WS_WV0 : WS_WINC + (size_t)1280 * D * 2)), hbuf, L == 0 ? NVR0 : NVR1, T, D}; pg8::StaticOrder S; S.init(g.M, g.N, G, bx);
                  pg8::EpiVT E{vtbuf, L == 0 ? NVR0 : NVR1};
                  pg8::gemm_phase<pg8::EpiVT, pg8::StaticOrder, true, true>(lds, g, S, E, tidb); }
            } else if (q == 4) {
                qk_pass(actbuf, L, as_global(args.in[I_QGAIN]), as_global(args.in[I_KGAIN]), cs, sn, gw, NGW, lane);
            } else if (q == 5) {
#ifndef NO_ATT
                if (L == 0) {
                    float lam; { const float s1 = wave_sum(as_global(args.in[I_LQ1])[lane] * as_global(args.in[I_LK1])[lane]), s2 = wave_sum(as_global(args.in[I_LQ2])[lane] * as_global(args.in[I_LK2])[lane]);
                        lam = __builtin_amdgcn_exp2f(s1 * LOG2E) - __builtin_amdgcn_exp2f(s2 * LOG2E) + 0.2f; }
                    for (int vbx = bx; vbx < 256; vbx += G)
                    for (int k = 0; k < 7; ++k) {
                        const int x = vbx & 7, j = vbx >> 3;
                        att::Unit U; U.qpitch = PQK0; U.kpitch = PQK0; U.opitch = D; U.has_sink = 0; U.sink2 = 0.f; U.qpos0 = 0; U.lat0 = 0; U.nctx = 4;
                        int b, hh, qrow; bool isB;
                        if (k < 2) { const int pidx = (k * 8 + x) * 4 + (j >> 3); b = pidx >> 2; hh = pidx & 3; qrow = b * SEQ + (j & 7) * 256; U.nlat = 32; isB = true; }
                        else if (k < 6) { const int idx = (k - 2) * 8 + x; b = idx >> 1; hh = (idx & 1) * 4 + (j >> 3); qrow = b * SEQ + (j & 7) * 256; U.nlat = 32; isB = false; }
                        else { if (vbx >= 192) continue; U.nlat = 0;
                            if (vbx < 64) { b = vbx >> 2; hh = vbx & 3; isB = true; } else { const int v = vbx - 64; b = v >> 3; hh = v & 7; isB = false; }
                            qrow = TLAT + b * CTX; }
                        const size_t krow0 = (size_t)(TLAT + b * CTX) * PQK0, krow1 = (size_t)(b * SEQ) * PQK0;
                        if (isB) {
                            U.Q = actbuf + (size_t)qrow * PQK0 + HB(10 + 2 * hh); U.Kctx = actbuf + krow0 + HB(18 + 2 * hh); U.Klat = actbuf + krow1 + HB(18 + 2 * hh);
                            U.VT = vtbuf + ((size_t)b * NVR0 + 128 + hh * 128) * NKEY; U.O = hbuf + (size_t)qrow * D + 512 + hh * 128;
                            att::unit<128, false, true>(lds, U, tid, wave, lane, lam, 0.8f, as_global(args.in[I_SUBG]));
                        } else {
                            U.Q = actbuf + (size_t)qrow * PQK0 + HB(hh); U.Kctx = actbuf + krow0 + HB(8 + (hh >> 2)); U.Klat = actbuf + krow1 + HB(8 + (hh >> 2));
                            U.VT = vtbuf + ((size_t)b * NVR0 + (hh >> 2) * 64) * NKEY; U.O = hbuf + (size_t)qrow * D + hh * 64;
                            att::unit<64, false, false>(lds, U, tid, wave, lane, 0.f, 0.f, nullptr);
                        }
                    }
                } else {
                    for (int vbx = bx; vbx < 256; vbx += G)
                    for (int k = 0; k < 8; ++k) {
                        const int x = vbx & 7, j = vbx >> 3, idx = k * 8 + x; const int b = idx >> 2, hh = (idx & 3) * 4 + (j >> 3), qb = (j + k) & 7; const int q0 = qb * 256, qrow = b * SEQ + q0;
                        const int s0 = q0 - 128 < 0 ? 0 : q0 - 128, s1 = q0 + 384 > SEQ ? SEQ : q0 + 384;
                        att::Unit U; U.qpitch = PQK1; U.kpitch = PQK1; U.opitch = D; U.has_sink = 1; U.sink2 = as_global(args.in[I_SINK])[hh] * LOG2E; U.qpos0 = q0; U.lat0 = s0; U.nctx = 4; U.nlat = (s1 - s0) >> 6;
                        U.Q = actbuf + (size_t)qrow * PQK1 + HB(hh); U.Kctx = actbuf + (size_t)(TLAT + b * CTX) * PQK1 + HB(16 + (hh >> 2)); U.Klat = actbuf + (size_t)(b * SEQ) * PQK1 + HB(16 + (hh >> 2));
                        U.VT = vtbuf + ((size_t)b * NVR1 + (hh >> 2) * 64) * NKEY; U.O = hbuf + (size_t)qrow * D + hh * 64;
                        att::unit2<true>(lds, U, tid, wave, lane);
                    }
                }
#endif
            } else if (q == 6) {
                if (false) combine_pass(ybuf, hbuf, as_global(args.in[I_LQ1]), as_global(args.in[I_LK1]), as_global(args.in[I_LQ2]), as_global(args.in[I_LK2]), as_global(args.in[I_SUBG]), 0.2f, gw, NGW, lane);
            }
        }
        if (ph + 1 < args.ph_hi) xcd_barrier(bar);
        if (MK_REPMASK != 0 && rep == 0 && ((ph >= 2 && ((MK_REPMASK >> ((ph - 2) % 12)) & 1)) || (ph == 0 && (MK_REPMASK & 0x10000)))) rep = 1; else { rep = 0; ++ph; }
    }
}


#ifdef MK_DUMP
__global__ void dump_k(const unsigned short* a, const unsigned short* b, float* out, size_t n) {
    for (size_t i = (size_t)blockIdx.x * blockDim.x + threadIdx.x; i < n; i += (size_t)gridDim.x * blockDim.x) {
        float v = __builtin_bit_cast(float, (unsigned)a[i] << 16); if (b) v += __builtin_bit_cast(float, (unsigned)b[i] << 16); out[i] = v; }
}
#endif
#ifndef MK_ONE_LAUNCH
#define MK_ONE_LAUNCH 1
#endif
extern "C" void kernel_launch(void* const* d_in, const int* in_sizes, int n_in, void* d_out, int out_size, void* d_ws, size_t ws_size, hipStream_t stream) {
    static int grid = 0;
    if (grid == 0) {
        if (n_in != 23 || ws_size < WS_END || out_size != TLAT * D) { fprintf(stderr, "kernel_launch: unexpected shapes (n_in %d, ws %zu, out %d); nothing launched\n", n_in, ws_size, out_size); grid = -1; return; }
        int dev = 0, cus = 0, per_cu = 0;
        (void)hipGetDevice(&dev); (void)hipDeviceGetAttribute(&cus, hipDeviceAttributeMultiprocessorCount, dev);
        if (hipFuncSetAttribute((const void*)mega, hipFuncAttributeMaxDynamicSharedMemorySize, LDS_BYTES) != hipSuccess) { fprintf(stderr, "kernel_launch: hipFuncSetAttribute failed\n"); grid = -1; return; }
        if (hipOccupancyMaxActiveBlocksPerMultiprocessor(&per_cu, (const void*)mega, 512, LDS_BYTES) != hipSuccess || per_cu < 1) { fprintf(stderr, "kernel_launch: occupancy query says %d\n", per_cu); per_cu = 1; }
        (void)hipGetLastError();
        grid = cus;
    }
    if (grid < 0) return;
    if (hipMemsetAsync(d_ws, 0, 65536, stream) != hipSuccess) { fprintf(stderr, "kernel_launch: memset of the barrier words failed\n"); return; }
    Args a{};
    for (int i = 0; i < 23; ++i) a.in[i] = (const float*)d_in[i];
    a.out = (float*)d_out; a.ws = (unsigned char*)d_ws;
#if MK_ONE_LAUNCH
    a.ph_lo = 0; a.ph_hi = NPHASE;
    void* kargs[] = {&a};
    hipError_t e = hipLaunchCooperativeKernel((const void*)mega, dim3(grid), dim3(512), kargs, LDS_BYTES, stream);
    if (e != hipSuccess) fprintf(stderr, "kernel_launch: cooperative launch failed: %s (grid %d)\n", hipGetErrorString(e), grid);
#else
#ifndef MK_STOP_PH
#define MK_STOP_PH NPHASE
#endif
    for (int ph = 0; ph < MK_STOP_PH; ++ph) {
        if (ph == 2 + 12 + 6) continue;
        a.ph_lo = ph; a.ph_hi = ph + 1;
        hipLaunchKernelGGL(mega, dim3(grid), dim3(512), LDS_BYTES, stream, a);
    }
#ifdef MK_DUMP
    { const unsigned short* pa = (const unsigned short*)((unsigned char*)d_ws + MK_DUMP_A); const unsigned short* pb = MK_DUMP_B ? (const unsigned short*)((unsigned char*)d_ws + MK_DUMP_B) : nullptr;
      hipLaunchKernelGGL(dump_k, dim3(2048), dim3(256), 0, stream, pa, pb, (float*)d_out, (size_t)MK_DUMP_N); }
#endif
#endif
}
```

```cpp
#include <hip/hip_runtime.h>
#include <hip/hip_cooperative_groups.h>
#include <cstdio>
#include <cstdint>
namespace cg = cooperative_groups;
namespace pg8 {
#define PG8_LAS __attribute__((address_space(3)))
typedef unsigned short bf16_t;
typedef short bf16x8 __attribute__((ext_vector_type(8)));
typedef float f32x4 __attribute__((ext_vector_type(4)));
typedef unsigned u32x4 __attribute__((ext_vector_type(4)));
constexpr int BM = 256, BK = 64, HALF = 128, HTB = HALF * BK * 2  , STAGE_BYTES = 8 * HTB, NXCD = 8, WGM = 4;

__host__ __device__ __forceinline__ int lds_byte(int r, int c) { const int st = (r >> 4) * 2 + (c >> 5), rr = r & 15, cc = c & 31, ob = rr * 64 + cc * 2; return st * 1024 + (ob ^ (((ob >> 9) & 1) << 5)); }
__host__ __device__ __forceinline__ void stage_rc(int b, int& R, int& C) { const int st = b / 1024, sb = b % 1024, swz = sb ^ (((sb >> 9) & 1) << 5); R = (st >> 1) * 16 + swz / 64; C = (st & 1) * 32 + (swz % 64) / 2; }
__host__ __device__ __forceinline__ int perm32(int rho) { const int n = rho >> 4, i = rho & 15; return 8 * (i >> 2) + 4 * n + (i & 3); }

struct Unit { int pm, pn; };
struct Gemm { const bf16_t* A; const bf16_t* Bt; int M, N, K; };

struct StaticOrder {
    int nM, nN, nwg, G, c; int wgm = WGM;
    __host__ __device__ void init(int M, int N, int G_, int c_) { nM = M / BM; nN = N / BM; nwg = nM * nN; G = G_; c = c_; }
    __host__ __device__ bool next(int i, Unit& u) const {
        const long L = (long)i * G + c; if (L >= nwg) return false;
        int wgid = (int)L; { const int q = nwg / NXCD, r = nwg % NXCD, xcd = wgid % NXCD, off = wgid / NXCD; wgid = (xcd < r ? xcd * (q + 1) : r * (q + 1) + (xcd - r) * q) + off; }
        const int nig = wgm * nN, gid = wgid / nig, fm = gid * wgm, gsz = (nM - fm) < wgm ? (nM - fm) : wgm;
        u.pm = fm + ((wgid % nig) % gsz); u.pn = (wgid % nig) / gsz; return true;
    }
    __device__ __forceinline__ void a_ready(const Unit&) const {}
    __device__ __forceinline__ void done(const Unit&) const {}
};

__device__ __forceinline__ unsigned cvt_pk_bf16(float lo, float hi) { unsigned r; asm volatile("v_cvt_pk_bf16_f32 %0, %1, %2" : "=v"(r) : "v"(lo), "v"(hi)); return r; }
typedef float f32x2 __attribute__((ext_vector_type(2)));
typedef unsigned u32x2 __attribute__((ext_vector_type(2)));
struct EpiBf16 {
    static constexpr bool PERM = true, AFTER_DRAIN = false;
    bf16_t* O; int ldc;
    __device__ __forceinline__ void operator()(const f32x4 (&acc)[2][2][4][2], const Unit& u, int wr, int wc, int fr, int fq) const {
        const int row0 = u.pm * BM + wr * 64 + fr; const int col0 = u.pn * BM + wc * 32 + 8 * fq;
#pragma unroll
        for (int ai = 0; ai < 2; ++ai)
#pragma unroll
            for (int m = 0; m < 4; ++m) { bf16_t* rowp = O + (size_t)(row0 + ai * HALF + m * 16) * ldc + col0;
#pragma unroll
                for (int bj = 0; bj < 2; ++bj) { const f32x4 v0 = acc[ai][bj][m][0], v1 = acc[ai][bj][m][1];
                    u32x4 w; w.x = cvt_pk_bf16(v0[0], v0[1]); w.y = cvt_pk_bf16(v0[2], v0[3]); w.z = cvt_pk_bf16(v1[0], v1[1]); w.w = cvt_pk_bf16(v1[2], v1[3]);
                    *(u32x4*)(rowp + bj * HALF) = w; } }
    }
};
__device__ __forceinline__ float silu_mul(float g, float u) { return g * __builtin_amdgcn_rcpf(1.0f + __builtin_amdgcn_exp2f(-1.4426950408889634f * g)) * u; }
struct EpiSwiGLU {
    static constexpr bool PERM = true, AFTER_DRAIN = false;
    bf16_t* O; int ldc;
    __device__ __forceinline__ void operator()(const f32x4 (&acc)[2][2][4][2], const Unit& u, int wr, int wc, int fr, int fq) const {
        const int row0 = u.pm * BM + wr * 64 + fr; const int col0 = u.pn * HALF + wc * 32 + 8 * fq;
#pragma unroll
        for (int ai = 0; ai < 2; ++ai)
#pragma unroll
            for (int m = 0; m < 4; ++m) { bf16_t* rowp = O + (size_t)(row0 + ai * HALF + m * 16) * ldc + col0;
                const f32x4 g0 = acc[ai][0][m][0], g1 = acc[ai][0][m][1], u0 = acc[ai][1][m][0], u1 = acc[ai][1][m][1];
                u32x4 w; w.x = cvt_pk_bf16(silu_mul(g0[0], u0[0]), silu_mul(g0[1], u0[1])); w.y = cvt_pk_bf16(silu_mul(g0[2], u0[2]), silu_mul(g0[3], u0[3]));
                w.z = cvt_pk_bf16(silu_mul(g1[0], u1[0]), silu_mul(g1[1], u1[1])); w.w = cvt_pk_bf16(silu_mul(g1[2], u1[2]), silu_mul(g1[3], u1[3]));
                *(u32x4*)rowp = w; }
    }
};
struct EpiY {
    static constexpr bool PERM = true, AFTER_DRAIN = false;
    bf16_t* O; int ldc; float* part;
    __device__ __forceinline__ void operator()(const f32x4 (&acc)[2][2][4][2], const Unit& u, int wr, int wc, int fr, int fq) const {
        const int row0 = u.pm * BM + wr * 64 + fr; const int col0 = u.pn * BM + wc * 32 + 8 * fq;
#pragma unroll
        for (int ai = 0; ai < 2; ++ai)
#pragma unroll
            for (int m = 0; m < 4; ++m) { const int row = row0 + ai * HALF + m * 16; bf16_t* rowp = O + (size_t)row * ldc + col0; float s = 0.f;
#pragma unroll
                for (int bj = 0; bj < 2; ++bj) { const f32x4 v0 = acc[ai][bj][m][0], v1 = acc[ai][bj][m][1];
                    s += (v0[0] * v0[0] + v0[1] * v0[1]) + (v0[2] * v0[2] + v0[3] * v0[3]) + (v1[0] * v1[0] + v1[1] * v1[1]) + (v1[2] * v1[2] + v1[3] * v1[3]);
                    u32x4 w; w.x = cvt_pk_bf16(v0[0], v0[1]); w.y = cvt_pk_bf16(v0[2], v0[3]); w.z = cvt_pk_bf16(v1[0], v1[1]); w.w = cvt_pk_bf16(v1[2], v1[3]);
                    *(u32x4*)(rowp + bj * HALF) = w; }
                s += __shfl_xor(s, 16); s += __shfl_xor(s, 32);
                if (fq == 0) part[(size_t)row * 16 + u.pn * 4 + wc] = s; }
    }
};
struct EpiVT {
    static constexpr bool PERM = true, AFTER_DRAIN = false;
    bf16_t* O; int nvr;
    __device__ __forceinline__ void operator()(const f32x4 (&acc)[2][2][4][2], const Unit& u, int wr, int wc, int fr, int fq) const {
        int b, k0; if (u.pn < 128) { b = u.pn >> 3; k0 = 256 + (u.pn & 7) * 256; } else { b = u.pn - 128; k0 = 0; }
        bf16_t* base = O + (size_t)b * nvr * 2304 + k0 + wc * 32 + 8 * fq; const int row0 = u.pm * BM + wr * 64 + fr;
#pragma unroll
        for (int ai = 0; ai < 2; ++ai)
#pragma unroll
            for (int m = 0; m < 4; ++m) { if (nvr == 768 && u.pm == 2 && ai == 1) continue;
                bf16_t* rowp = base + (size_t)(row0 + ai * HALF + m * 16) * 2304;
#pragma unroll
                for (int bj = 0; bj < 2; ++bj) { const f32x4 v0 = acc[ai][bj][m][0], v1 = acc[ai][bj][m][1];
                    u32x4 w; w.x = cvt_pk_bf16(v0[0], v0[1]); w.y = cvt_pk_bf16(v0[2], v0[3]); w.z = cvt_pk_bf16(v1[0], v1[1]); w.w = cvt_pk_bf16(v1[2], v1[3]);
                    *(u32x4*)(rowp + bj * HALF) = w; } }
    }
};

struct EpiQK {
    static constexpr bool PERM = true, AFTER_DRAIN = false;
    bf16_t* O; int ldc; int layer; const float* cs; const float* sn; const float* qgain; const float* kgain; int tlat; float c2;
    __device__ __forceinline__ void operator()(const f32x4 (&acc)[2][2][4][2], const Unit& u, int wr, int wc, int fr, int fq) const {
        const int H = 4 * u.pn + wc;
        if (H >= (layer == 0 ? 26 : 20)) return;
        bool is_q, do_rms;
        if (layer == 0) { is_q = H < 8 || (H >= 10 && H < 18); do_rms = H < 10; }
        else { is_q = H < 16; do_rms = false; }
        const long gdelta = (layer == 0 && H >= 8) ? (long)(kgain - qgain) : 0l; const float* gain = qgain + gdelta;
        const float sc = is_q ? c2 : 1.0f;
        f32x4 g1[2], g2[2];
#pragma unroll
        for (int n = 0; n < 2; ++n) { if (do_rms) { g1[n] = *(const f32x4*)(gain + 8 * fq + 4 * n); g2[n] = *(const f32x4*)(gain + 32 + 8 * fq + 4 * n); } else { g1[n] = (f32x4){1.f, 1.f, 1.f, 1.f}; g2[n] = g1[n]; } }
        const int row0 = u.pm * BM + wr * 64 + fr; const int col0 = u.pn * BM + wc * 32 + 8 * fq;
#pragma unroll
        for (int ai = 0; ai < 2; ++ai)
#pragma unroll
            for (int m = 0; m < 4; ++m) { const int row = row0 + ai * HALF + m * 16; bf16_t* rowp = O + (size_t)row * ldc + col0;
                f32x4 x1[2] = {acc[ai][0][m][0], acc[ai][0][m][1]}, x2[2] = {acc[ai][1][m][0], acc[ai][1][m][1]};
                if (do_rms) { float s = 0.f;
#pragma unroll
                    for (int n = 0; n < 2; ++n) s += (x1[n][0] * x1[n][0] + x1[n][1] * x1[n][1]) + (x1[n][2] * x1[n][2] + x1[n][3] * x1[n][3]) + (x2[n][0] * x2[n][0] + x2[n][1] * x2[n][1]) + (x2[n][2] * x2[n][2] + x2[n][3] * x2[n][3]);
                    s += __shfl_xor(s, 16); s += __shfl_xor(s, 32);
                    const float rinv = __builtin_amdgcn_rsqf(s * (1.0f / 64.0f) + 1e-6f);
#pragma unroll
                    for (int n = 0; n < 2; ++n) { x1[n] = x1[n] * rinv * g1[n]; x2[n] = x2[n] * rinv * g2[n]; } }
                if (row < tlat) { const int pos = row & 2047;
#pragma unroll
                    for (int n = 0; n < 2; ++n) { const f32x4 c = *(const f32x4*)(cs + pos * 32 + 8 * fq + 4 * n), s = *(const f32x4*)(sn + pos * 32 + 8 * fq + 4 * n);
                        const f32x4 a = x1[n] * c - x2[n] * s, b = x2[n] * c + x1[n] * s; x1[n] = a; x2[n] = b; } }
                u32x4 w1, w2;
                w1.x = cvt_pk_bf16(x1[0][0] * sc, x1[0][1] * sc); w1.y = cvt_pk_bf16(x1[0][2] * sc, x1[0][3] * sc); w1.z = cvt_pk_bf16(x1[1][0] * sc, x1[1][1] * sc); w1.w = cvt_pk_bf16(x1[1][2] * sc, x1[1][3] * sc);
                w2.x = cvt_pk_bf16(x2[0][0] * sc, x2[0][1] * sc); w2.y = cvt_pk_bf16(x2[0][2] * sc, x2[0][3] * sc); w2.z = cvt_pk_bf16(x2[1][0] * sc, x2[1][1] * sc); w2.w = cvt_pk_bf16(x2[1][2] * sc, x2[1][3] * sc);
                *(u32x4*)rowp = w1; *(u32x4*)(rowp + HALF) = w2;
                }
    }
};
template <class Epi, class Sched, bool ALIGN_EPI = false, bool SP2 = false>
__device__ __forceinline__ void gemm_phase(PG8_LAS unsigned char* lds, const Gemm g, const Sched& S, const Epi& E, const int tid_in) {
    const int tid = tid_in, wid = __builtin_amdgcn_readfirstlane(tid >> 6), lane = tid & 63, wr = wid >> 2, wc = wid & 3, fr = lane & 15, fq = lane >> 4;
    const int K = g.K, nt = K / BK;
    unsigned voffA[2], voffB[2];
#pragma unroll
    for (int i = 0; i < 2; ++i) { int R, C; stage_rc(tid * 16 + i * 8192, R, C); const int Rb = Epi::PERM ? ((R & ~31) + perm32(R & 31)) : R;
        voffA[i] = (unsigned)(R * K + C) * 2u; voffB[i] = (unsigned)(Rb * K + C) * 2u; }
    const size_t kstep = (size_t)(BK * 2);
    const size_t hstep = (size_t)HALF * K * 2;
    const size_t tstep = 2 * hstep;
    const unsigned ldsw = (unsigned)wid * 1024u;
    const int aoff = lds_byte(wr * 64 + fr, fq * 8), boff = lds_byte(wc * 32 + fr, fq * 8);
#define PG8_SA(b, h) (((b) * 2 + (h)) * HTB)
#define PG8_SB(b, h) ((4 + (b) * 2 + (h)) * HTB)
#define PG8_STAGE(bufoff, gbase, voff) do { _Pragma("unroll") for (int _i = 0; _i < 2; ++_i) \
        __builtin_amdgcn_global_load_lds((const unsigned*)((const char*)(gbase) + (voff)[_i]), (PG8_LAS unsigned*)(lds + (bufoff) + ldsw + _i * 8192), 16, 0, 0); } while (0)
#define PG8_LDA(dst, b, h) do { _Pragma("unroll") for (int m = 0; m < 4; ++m) _Pragma("unroll") for (int k = 0; k < 2; ++k) dst[m][k] = *(const PG8_LAS bf16x8*)(lds + PG8_SA(b, h) + aoff + m * 2048 + k * 1024); } while (0)
#define PG8_LDB(dst, b, h) do { _Pragma("unroll") for (int n = 0; n < 2; ++n) _Pragma("unroll") for (int k = 0; k < 2; ++k) dst[n][k] = *(const PG8_LAS bf16x8*)(lds + PG8_SB(b, h) + boff + n * 2048 + k * 1024); } while (0)
#define PG8_MMA(ai, bj, At, Bt) do { __builtin_amdgcn_s_setprio(1); _Pragma("unroll") for (int m = 0; m < 4; ++m) _Pragma("unroll") for (int n = 0; n < 2; ++n) _Pragma("unroll") for (int k = 0; k < 2; ++k) \
        acc[ai][bj][m][n] = __builtin_amdgcn_mfma_f32_16x16x32_bf16(Bt[n][k], At[m][k], acc[ai][bj][m][n], 0, 0, 0); __builtin_amdgcn_s_setprio(0); } while (0)
#define PG8_WAIT_V(n) asm volatile("s_waitcnt vmcnt(" #n ")" ::: "memory")
#define PG8_WAIT_L(n) asm volatile("s_waitcnt lgkmcnt(" #n ")" ::: "memory")
#define PG8_BAR __builtin_amdgcn_s_barrier()
#define PG8_SCHED __builtin_amdgcn_sched_barrier(0)
    Unit cur, nxt; int ui = 0;
    if (!S.next(0, cur)) return;
    f32x4 acc[2][2][4][2];
#pragma unroll
    for (int a = 0; a < 2; ++a)
#pragma unroll
        for (int b = 0; b < 2; ++b)
#pragma unroll
            for (int m = 0; m < 4; ++m)
#pragma unroll
                for (int n = 0; n < 2; ++n) acc[a][b][m][n] = (f32x4){0.f, 0.f, 0.f, 0.f};
    bf16x8 At[4][2], B0[2][2], B1[2][2];
    const char* cA = (const char*)g.A + (size_t)cur.pm * tstep; const char* cB = (const char*)g.Bt + (size_t)cur.pn * tstep;
    S.a_ready(cur);
    if constexpr (SP2) {
        PG8_STAGE(PG8_SB(0, 0), cB, voffB); PG8_STAGE(PG8_SB(0, 1), cB + hstep, voffB); PG8_STAGE(PG8_SA(0, 0), cA, voffA); PG8_STAGE(PG8_SA(0, 1), cA + hstep, voffA);
        if (wr == 1) PG8_BAR;
        PG8_WAIT_V(2); PG8_BAR;
        PG8_STAGE(PG8_SB(1, 0), cB + kstep, voffB); PG8_STAGE(PG8_SA(1, 0), cA + kstep, voffA); PG8_STAGE(PG8_SB(1, 1), cB + hstep + kstep, voffB);
        PG8_WAIT_V(6); PG8_BAR;
    } else {
        PG8_STAGE(PG8_SB(0, 0), cB, voffB); PG8_STAGE(PG8_SA(0, 0), cA, voffA); PG8_STAGE(PG8_SB(0, 1), cB + hstep, voffB); PG8_STAGE(PG8_SA(0, 1), cA + hstep, voffA);
        if (wr == 1) PG8_BAR;
        PG8_WAIT_V(4); PG8_BAR;
        PG8_STAGE(PG8_SB(1, 0), cB + kstep, voffB); PG8_STAGE(PG8_SA(1, 0), cA + kstep, voffA); PG8_STAGE(PG8_SB(1, 1), cB + hstep + kstep, voffB);
        PG8_WAIT_V(6); PG8_BAR;
    }
    for (;;) {
        const bool has_next = S.next(ui + 1, nxt);
        const char* nA = has_next ? (const char*)g.A + (size_t)nxt.pm * tstep : cA; const char* nB = has_next ? (const char*)g.Bt + (size_t)nxt.pn * tstep : cB;
        for (int t = 0; t < nt; t += 2) {
            const bool last = (t == nt - 2);
            const char* a1 = cA + (size_t)(t + 1) * kstep;
            const char* a2 = last ? nA : cA + (size_t)(t + 2) * kstep; const char* b2 = last ? nB : cB + (size_t)(t + 2) * kstep;
            const char* a3 = a2 + kstep; const char* b3 = b2 + kstep;
            if (last && has_next) S.a_ready(nxt);
            if constexpr (SP2) {
            PG8_LDB(B0, 0, 0); PG8_LDB(B1, 0, 1); PG8_SCHED; PG8_LDA(At, 0, 0); PG8_STAGE(PG8_SA(1, 1), a1 + hstep, voffA);
            PG8_WAIT_V(8); PG8_WAIT_L(0); PG8_BAR; PG8_MMA(0, 0, At, B0); PG8_MMA(0, 1, At, B1); PG8_BAR; PG8_SCHED;
            PG8_LDA(At, 0, 1); PG8_STAGE(PG8_SB(0, 0), b2, voffB); PG8_STAGE(PG8_SB(0, 1), b2 + hstep, voffB); PG8_STAGE(PG8_SA(0, 0), a2, voffA);
            PG8_WAIT_V(8); PG8_WAIT_L(0); PG8_BAR; PG8_MMA(1, 0, At, B0); PG8_MMA(1, 1, At, B1); PG8_BAR; PG8_SCHED;
            PG8_LDB(B0, 1, 0); PG8_LDB(B1, 1, 1); PG8_SCHED; PG8_LDA(At, 1, 0); PG8_STAGE(PG8_SA(0, 1), a2 + hstep, voffA);
            PG8_WAIT_V(8); PG8_WAIT_L(0); PG8_BAR; PG8_MMA(0, 0, At, B0); PG8_MMA(0, 1, At, B1); PG8_BAR; PG8_SCHED;
            PG8_LDA(At, 1, 1); PG8_STAGE(PG8_SB(1, 0), b3, voffB); PG8_STAGE(PG8_SB(1, 1), b3 + hstep, voffB); PG8_STAGE(PG8_SA(1, 0), a3, voffA);
            PG8_WAIT_V(8); PG8_WAIT_L(0); PG8_BAR; PG8_MMA(1, 0, At, B0); PG8_MMA(1, 1, At, B1); PG8_BAR; PG8_SCHED;
            } else {
            PG8_LDB(B0, 0, 0); PG8_SCHED; PG8_LDA(At, 0, 0); PG8_STAGE(PG8_SA(1, 1), a1 + hstep, voffA);
            PG8_WAIT_L(8); PG8_BAR; PG8_WAIT_L(0); PG8_MMA(0, 0, At, B0); PG8_BAR; PG8_SCHED;
            PG8_LDB(B1, 0, 1); PG8_STAGE(PG8_SB(0, 0), b2, voffB);
            PG8_BAR; PG8_WAIT_L(0); PG8_MMA(0, 1, At, B1); PG8_BAR;
            PG8_LDA(At, 0, 1); PG8_STAGE(PG8_SA(0, 0), a2, voffA);
            PG8_BAR; PG8_WAIT_L(0); PG8_MMA(1, 0, At, B0); PG8_BAR; PG8_SCHED;
            PG8_STAGE(PG8_SB(0, 1), b2 + hstep, voffB);
            PG8_WAIT_V(6); PG8_BAR; PG8_MMA(1, 1, At, B1); PG8_BAR;
            PG8_LDB(B0, 1, 0); PG8_SCHED; PG8_LDA(At, 1, 0); PG8_STAGE(PG8_SA(0, 1), a2 + hstep, voffA);
            PG8_WAIT_L(8); PG8_BAR; PG8_WAIT_L(0); PG8_MMA(0, 0, At, B0); PG8_BAR; PG8_SCHED;
            PG8_LDB(B1, 1, 1); PG8_STAGE(PG8_SB(1, 0), b3, voffB);
            PG8_BAR; PG8_WAIT_L(0); PG8_MMA(0, 1, At, B1); PG8_BAR;
            PG8_LDA(At, 1, 1); PG8_STAGE(PG8_SA(1, 0), a3, voffA);
            PG8_BAR; PG8_WAIT_L(0); PG8_MMA(1, 0, At, B0); PG8_BAR; PG8_SCHED;
            PG8_STAGE(PG8_SB(1, 1), b3 + hstep, voffB);
            PG8_WAIT_V(6); PG8_BAR; PG8_MMA(1, 1, At, B1); PG8_BAR;
            }
        }
        if constexpr (ALIGN_EPI) { if (wr == 0) PG8_BAR; }
        if constexpr (!Epi::AFTER_DRAIN) { E(acc, cur, wr, wc, fr, fq); S.done(cur); }
        if (!has_next) break;
#pragma unroll
        for (int a = 0; a < 2; ++a)
#pragma unroll
            for (int b = 0; b < 2; ++b)
#pragma unroll
                for (int m = 0; m < 4; ++m)
#pragma unroll
                    for (int n = 0; n < 2; ++n) acc[a][b][m][n] = (f32x4){0.f, 0.f, 0.f, 0.f};
        cur = nxt; cA = nA; cB = nB; ++ui;
        if constexpr (ALIGN_EPI) { if (wr == 1) PG8_BAR; }
    }
    PG8_WAIT_V(0);
    if constexpr (!ALIGN_EPI) { if (wr == 0) PG8_BAR; }
    PG8_BAR;
    if constexpr (Epi::AFTER_DRAIN) { E.fused(acc, cur, wr, wc, fr, fq, lds, wid, lane); S.done(cur); }
#undef PG8_SA
#undef PG8_SB
#undef PG8_STAGE
#undef PG8_LDA
#undef PG8_LDB
#undef PG8_MMA
#undef PG8_WAIT_V
#undef PG8_WAIT_L
#undef PG8_BAR
#undef PG8_SCHED
}
}

#define LAS __attribute__((address_space(3)))
typedef unsigned short bf16;
typedef float f32x4 __attribute__((ext_vector_type(4)));
typedef float f32x2v __attribute__((ext_vector_type(2)));
typedef float f32x16 __attribute__((ext_vector_type(16)));
typedef short bf16x8 __attribute__((ext_vector_type(8)));
typedef unsigned u32x4 __attribute__((ext_vector_type(4)));
typedef unsigned u32x2 __attribute__((ext_vector_type(2)));

constexpr int D = 1024, NB = 16, SEQ = 2048, CTX = 256, FF = 2816;
constexpr int TLAT = NB * SEQ;
constexpr int TCTX = NB * CTX;
constexpr int T = TLAT + TCTX;
constexpr int NKEY = CTX + SEQ;
constexpr int NMOD = 9 * D;
constexpr int PQK0 = 1792, PQK1 = 1280;
constexpr int NVR0 = 768, NVR1 = 256;
constexpr float EPS = 1e-6f;
constexpr float C2 = 0.125f * 1.4426950408889634f;
constexpr float LOG2E = 1.4426950408889634f;

constexpr size_t MiB = 1u << 20;
constexpr size_t WS_MOD = 1 * MiB;
constexpr size_t WS_ROPE = 3 * MiB;
constexpr size_t WS_PART = 4 * MiB;
constexpr size_t WS_XCTX = 7 * MiB;
constexpr size_t WS_WGU = 23 * MiB;
constexpr size_t WGU_BYTES = (size_t)2 * FF * D * 2;
constexpr size_t WS_WD = 67 * MiB;
constexpr size_t WD_BYTES = (size_t)D * FF * 2;
constexpr size_t WS_WQK0 = 89 * MiB;
constexpr size_t WS_WV0 = WS_WQK0 + (size_t)1792 * 1024 * 2;
constexpr size_t WS_WOUT0 = 94 * MiB;
constexpr size_t WS_WINC = 96 * MiB;
constexpr size_t WS_WOUTC = 99 * MiB;
constexpr size_t WS_H = 101 * MiB;
constexpr size_t WS_Y = 173 * MiB;
constexpr size_t WS_ACT = 245 * MiB;
constexpr size_t WS_VT = WS_ACT + 126 * MiB;
constexpr size_t WS_END = 443 * MiB;
static_assert(WS_WV0 + (size_t)768 * 1024 * 2 <= WS_WOUT0, "ws map");
static_assert(WS_VT + (size_t)NB * NVR0 * NKEY * 2 <= WS_END && (size_t)T * PQK0 * 2 <= 126 * MiB, "ws map");
static_assert(WS_ACT + (size_t)T * FF * 2 <= WS_END, "ws map");

constexpr int RING_BYTES = 131072, LDS_BYTES = 135168;
constexpr int NWAVES = 8;

struct Args { const float* in[23]; float* out; unsigned char* ws; int ph_lo, ph_hi; };
enum { I_X = 0, I_C, I_CTX, I_CCTX, I_WMOD, I_BMOD, I_GPRE, I_GPOST, I_WG, I_WU, I_WD, I_WINAB, I_WOUTAB, I_QGAIN, I_KGAIN, I_LQ1, I_LK1, I_LQ2, I_LK2, I_SUBG, I_WINC, I_WOUTC, I_SINK };

template <class Tp> __device__ __forceinline__ Tp* as_global(Tp* p) { return (Tp*)(__attribute__((address_space(1))) Tp*)(unsigned long long)p; }
__device__ __forceinline__ float wave_sum(float v) {
#pragma unroll
    for (int o = 1; o < 64; o <<= 1) v += __shfl_xor(v, o);
    return v;
}
__device__ __forceinline__ unsigned f2bf(float f) { unsigned u = __builtin_bit_cast(unsigned, f); return (u + 0x7fffu + ((u >> 16) & 1u)) >> 16; }
__device__ __forceinline__ unsigned pk2(float lo, float hi) { return f2bf(lo) | (f2bf(hi) << 16); }
typedef float f32x2_t __attribute__((ext_vector_type(2))); typedef __bf16 bf16x2_t __attribute__((ext_vector_type(2)));
__device__ __forceinline__ unsigned cvtpk_s(float lo, float hi) { f32x2_t v = {lo, hi}; bf16x2_t b = __builtin_convertvector(v, bf16x2_t); return __builtin_bit_cast(unsigned, b); }
__device__ __forceinline__ float bf_lo(unsigned w) { return __builtin_bit_cast(float, w << 16); }
__device__ __forceinline__ float bf_hi(unsigned w) { return __builtin_bit_cast(float, w & 0xffff0000u); }

__device__ __forceinline__ void transpose_item(const float* W, int K, int N, int k0, int n0, bf16* dst, LAS float* scr, int lane) {
    f32x4 wv[8];
#pragma unroll
    for (int i = 0; i < 8; ++i) wv[i] = __builtin_nontemporal_load((const f32x4*)(W + (size_t)(k0 + 8 * i + (lane >> 3)) * N + n0 + 4 * (lane & 7)));
#pragma unroll
    for (int i = 0; i < 8; ++i) { LAS float* sp = scr + (8 * i + (lane >> 3)) * 33 + 4 * (lane & 7); sp[0] = wv[i][0]; sp[1] = wv[i][1]; sp[2] = wv[i][2]; sp[3] = wv[i][3]; }
    asm volatile("s_waitcnt lgkmcnt(0)" ::: "memory");
    const int c = lane & 7;
#pragma unroll
    for (int j = 0; j < 4; ++j) { const int n = (lane >> 3) + 8 * j; const LAS float* s = scr + (8 * c) * 33 + n;
        u32x4 o; o.x = pk2(s[0 * 33], s[1 * 33]); o.y = pk2(s[2 * 33], s[3 * 33]); o.z = pk2(s[4 * 33], s[5 * 33]); o.w = pk2(s[6 * 33], s[7 * 33]);
        *(u32x4*)(dst + (size_t)n * K + k0 + 8 * c) = o; }
    asm volatile("s_waitcnt lgkmcnt(0)" ::: "memory");
}

__device__ __forceinline__ void prologue(const Args& a, LAS unsigned char* lds, int gw, int NGW, int wave, int lane, int tid, int G) {
    unsigned char* ws = a.ws;
    {
        LAS float* scr = (LAS float*)(lds + wave * 16384);
        constexpr int IT_G = (D / 64) * (FF / 32);
        constexpr int IT_D = (FF / 64) * (D / 32);
        constexpr int IT_AB = (D / 64) * (2304 / 32);
        constexpr int IT_O = (D / 64) * (D / 32);
        constexpr int IT_C = (D / 64) * (1536 / 32);
        constexpr int NITEMS = 8 * IT_G + 4 * IT_D + IT_AB + IT_O + IT_C + IT_O;
        for (int it = gw; it < NITEMS; it += NGW) {
            int r = it;
            if (r < 8 * IT_G) {
                const int mat = r / IT_G, q = r % IT_G, mi = mat >> 1, which = mat & 1;
                const int nblk = FF / 32, kb = q / nblk, nb = q % nblk, n0 = nb * 32;
                const float* W = as_global(a.in[which ? I_WU : I_WG]) + (size_t)mi * D * FF;
                bf16* dst = (bf16*)(ws + WS_WGU + (size_t)mi * WGU_BYTES) + (size_t)((n0 >> 7) * 256 + which * 128 + (n0 & 127)) * D;
                transpose_item(W, D, FF, kb * 64, n0, dst, scr, lane); continue; }
            r -= 8 * IT_G;
            if (r < 4 * IT_D) {
                const int mi = r / IT_D, q = r % IT_D; const int nblk = D / 32, kb = q / nblk, nb = q % nblk, n0 = nb * 32;
                const float* W = as_global(a.in[I_WD]) + (size_t)mi * FF * D;
                bf16* dst = (bf16*)(ws + WS_WD + (size_t)mi * WD_BYTES) + (size_t)n0 * FF;
                transpose_item(W, FF, D, kb * 64, n0, dst, scr, lane); continue; }
            r -= 4 * IT_D;
            if (r < IT_AB) {
                const int nblk = 2304 / 32, kb = r / nblk, nb = r % nblk, n0 = nb * 32;
                bf16* dst;
                if (n0 >= 640 && n0 < 768) dst = (bf16*)(ws + WS_WV0) + (size_t)(n0 - 640) * D;
                else if (n0 >= 1792) dst = (bf16*)(ws + WS_WV0) + (size_t)(128 + n0 - 1792) * D;
                else { const int pc = n0 < 640 ? n0 : n0 - 128, Hh = pc >> 6, dh = (pc >> 5) & 1; dst = (bf16*)(ws + WS_WQK0) + (size_t)(256 * (Hh >> 2) + 128 * dh + 32 * (Hh & 3)) * D; }
                transpose_item(as_global(a.in[I_WINAB]), D, 2304, kb * 64, n0, dst, scr, lane); continue; }
            r -= IT_AB;
            if (r < IT_O) { const int nblk = D / 32, kb = r / nblk, nb = r % nblk, n0 = nb * 32;
                transpose_item(as_global(a.in[I_WOUTAB]), D, D, kb * 64, n0, (bf16*)(ws + WS_WOUT0) + (size_t)n0 * D, scr, lane); continue; }
            r -= IT_O;
            if (r < IT_C) { const int nblk = 1536 / 32, kb = r / nblk, nb = r % nblk, n0 = nb * 32;
                const int Hh = n0 >> 6, dh = (n0 >> 5) & 1; const int drow = n0 < 1280 ? 256 * (Hh >> 2) + 128 * dh + 32 * (Hh & 3) : n0;
                transpose_item(as_global(a.in[I_WINC]), D, 1536, kb * 64, n0, (bf16*)(ws + WS_WINC) + (size_t)drow * D, scr, lane); continue; }
            r -= IT_C;
            { const int nblk = D / 32, kb = r / nblk, nb = r % nblk, n0 = nb * 32;
                transpose_item(as_global(a.in[I_WOUTC]), D, D, kb * 64, n0, (bf16*)(ws + WS_WOUTC) + (size_t)n0 * D, scr, lane); }
        }
    }
    {
        float* cs = (float*)(ws + WS_ROPE); float* sn = cs + SEQ * 32;
        for (int i = blockIdx.x * 512 + tid; i < SEQ * 32; i += G * 512) {
            const int pos = i >> 5, j = i & 31; const float p = (j < 16) ? (float)(pos >> 6) : (float)(pos & 63);
            const float inv = __builtin_amdgcn_exp2f(-(float)(j & 15) * (13.287712379549449f / 16.0f));
            const float ang = p * inv; cs[i] = __cosf(ang); sn[i] = __sinf(ang);
        }
    }
    __syncthreads();
    {
        LAS float* sc = (LAS float*)lds;
        LAS float* red = (LAS float*)(lds + 17 * 1024 * 4);
        for (int i = tid; i < 17 * 1024; i += 512) { const float v = (i < 16 * 1024) ? as_global(a.in[I_C])[i] : as_global(a.in[I_CCTX])[i - 16 * 1024];
            sc[i] = v * __builtin_amdgcn_rcpf(1.0f + __builtin_amdgcn_exp2f(-LOG2E * v)); }
        __syncthreads();
        float* mod = (float*)(ws + WS_MOD);
        for (int it = blockIdx.x; it < 2 * (NMOD / 64); it += G) {
            const int l = it / (NMOD / 64), cg_ = it % (NMOD / 64), col = cg_ * 64 + lane;
            const float* wp = as_global(a.in[I_WMOD]) + (size_t)l * D * NMOD + (size_t)(wave * 128) * NMOD + col;
            float acc[17];
#pragma unroll
            for (int m = 0; m < 17; ++m) acc[m] = 0.f;
            for (int k = 0; k < 128; k += 8) {
                float w[8];
#pragma unroll
                for (int u = 0; u < 8; ++u) w[u] = __builtin_nontemporal_load(wp + (size_t)(k + u) * NMOD);
#pragma unroll
                for (int u = 0; u < 8; ++u)
#pragma unroll
                    for (int m = 0; m < 17; ++m) acc[m] += sc[m * 1024 + wave * 128 + k + u] * w[u];
            }
#pragma unroll
            for (int m = 0; m < 17; ++m) red[(wave * 17 + m) * 64 + lane] = acc[m];
            __syncthreads();
            for (int o = tid; o < 17 * 64; o += 512) { const int m = o >> 6, ln = o & 63; float s = 0.f;
#pragma unroll
                for (int w = 0; w < 8; ++w) s += red[(w * 17 + m) * 64 + ln];
                mod[((size_t)l * 17 + m) * NMOD + cg_ * 64 + ln] = s + as_global(a.in[I_BMOD])[l * NMOD + cg_ * 64 + ln]; }
            __syncthreads();
        }
    }
}

struct ResidParams {
    const float* xsrc_lat; const float* xsrc_ctx;
    float* xdst_lat; float* xdst_ctx;
    const bf16* y; const float* part;
    bf16* h;
    const float* gate; const float* gpost;
    const float* shift; const float* scale; const float* gpre;
    float res_w; int nrows; int has_y, has_h, write_x; int row_lo;
};
__device__ __forceinline__ void resid_pass(const ResidParams& P, int gw, int NGW, int lane) {
    const int nitems = P.nrows >> 2;
    for (int it = gw; it < nitems; it += NGW) {
        const int row0 = P.row_lo + it * 4; const int mi = row0 < TLAT ? (row0 >> 11) : 16;
        f32x4 a1[4], a2[4], a3[4];
#pragma unroll
        for (int j = 0; j < 4; ++j) { const int c = 4 * lane + 256 * j;
            if (P.has_y) { const f32x4 g = *(const f32x4*)(P.gate + (size_t)mi * NMOD + c), gp = *(const f32x4*)(P.gpost + c); a1[j] = g * gp * P.res_w; } else a1[j] = (f32x4){0.f, 0.f, 0.f, 0.f};
            if (P.has_h) { const f32x4 sc = *(const f32x4*)(P.scale + (size_t)mi * NMOD + c), sh = *(const f32x4*)(P.shift + (size_t)mi * NMOD + c), gp = *(const f32x4*)(P.gpre + c);
                a2[j] = gp * (sc + 1.0f); a3[j] = sh; } else { a2[j] = (f32x4){0.f, 0.f, 0.f, 0.f}; a3[j] = a2[j]; } }
#pragma unroll 1
        for (int rp = 0; rp < 4; rp += 2) {
            f32x4 x[2][4]; u32x2 yw[2][4]; float ps[2];
#pragma unroll
            for (int q = 0; q < 2; ++q) { const int row = row0 + rp + q;
                const float* xs = row < TLAT ? P.xsrc_lat + (size_t)row * D : P.xsrc_ctx + (size_t)(row - TLAT) * D;
#pragma unroll
                for (int j = 0; j < 4; ++j) x[q][j] = __builtin_nontemporal_load((const f32x4*)(xs + 4 * lane + 256 * j));
                if (P.has_y) { ps[q] = lane < 16 ? P.part[(size_t)row * 16 + lane] : 0.f;
#pragma unroll
                    for (int j = 0; j < 4; ++j) yw[q][j] = __builtin_nontemporal_load((const u32x2*)(P.y + (size_t)row * D + 4 * lane + 256 * j)); } }
#pragma unroll
            for (int q = 0; q < 2; ++q) { const int row = row0 + rp + q;
                float* xd = row < TLAT ? P.xdst_lat + (size_t)row * D : P.xdst_ctx + (size_t)(row - TLAT) * D;
                if (P.has_y) {
                    const float ss = wave_sum(ps[q]); const float rinv = rsqrtf(ss * (1.0f / D) + EPS);
#pragma unroll
                    for (int j = 0; j < 4; ++j) { const u32x2 w = yw[q][j];
                        const f32x4 yv = (f32x4){bf_lo(w.x), bf_hi(w.x), bf_lo(w.y), bf_hi(w.y)}; x[q][j] = x[q][j] + a1[j] * (yv * rinv); }
                }
                if (P.write_x) {
#pragma unroll
                    for (int j = 0; j < 4; ++j) __builtin_nontemporal_store(x[q][j], (f32x4*)(xd + 4 * lane + 256 * j));
                }
                if (P.has_h) {
                    float s2 = 0.f;
#pragma unroll
                    for (int j = 0; j < 4; ++j) s2 += (x[q][j][0] * x[q][j][0] + x[q][j][1] * x[q][j][1]) + (x[q][j][2] * x[q][j][2] + x[q][j][3] * x[q][j][3]);
                    const float rinv2 = rsqrtf(wave_sum(s2) * (1.0f / D) + EPS);
#pragma unroll
                    for (int j = 0; j < 4; ++j) { const f32x4 hv = (x[q][j] * rinv2) * a2[j] + a3[j]; u32x2 w; w.x = pk2(hv[0], hv[1]); w.y = pk2(hv[2], hv[3]);
                        *(u32x2*)(P.h + (size_t)row * D + 4 * lane + 256 * j) = w; }
                }
            }
        }
    }
}

__device__ __forceinline__ void qk_pass(bf16* Pq, int layer, const float* qgain, const float* kgain, const float* cs, const float* sn, int gw, int NGW, int lane) {
    const int pitch = layer == 0 ? PQK0 : PQK1, nheads = layer == 0 ? 26 : 20, nrows = layer == 0 ? T : TLAT;
    const int hs = lane >> 2, i = lane & 3;
    for (int row = gw; row < nrows; row += NGW) {
        const bool lat = row < TLAT; const int pos = row & (SEQ - 1);
        bf16* rp = Pq + (size_t)row * pitch;
        u32x4 w1[2], w2[2]; f32x4 cva, cvb, sva, svb;
#pragma unroll
        for (int st = 0; st < 2; ++st) { const int head = st * 16 + hs; if (head < nheads) { w1[st] = *(const u32x4*)(rp + head * 64 + 8 * i); w2[st] = *(const u32x4*)(rp + head * 64 + 32 + 8 * i); } }
        if (lat) { cva = *(const f32x4*)(cs + pos * 32 + 8 * i); cvb = *(const f32x4*)(cs + pos * 32 + 8 * i + 4); sva = *(const f32x4*)(sn + pos * 32 + 8 * i); svb = *(const f32x4*)(sn + pos * 32 + 8 * i + 4); }
        else { cva = (f32x4){1.f, 1.f, 1.f, 1.f}; cvb = cva; sva = (f32x4){0.f, 0.f, 0.f, 0.f}; svb = sva; }
        const float cv[8] = {cva[0], cva[1], cva[2], cva[3], cvb[0], cvb[1], cvb[2], cvb[3]}, sv[8] = {sva[0], sva[1], sva[2], sva[3], svb[0], svb[1], svb[2], svb[3]};
#pragma unroll
        for (int st = 0; st < 2; ++st) {
            const int head = st * 16 + hs; if (head >= nheads) continue;
            bool is_q, do_rms, do_rope; const float* gain = qgain;
            if (layer == 0) { is_q = head < 8 || (head >= 10 && head < 18); do_rms = head < 10; gain = head < 8 ? qgain : kgain; do_rope = lat; }
            else { is_q = head < 16; do_rms = false; do_rope = true; }
            if (!lat && !is_q && !do_rms) continue;
            float x1[8], x2[8];
#pragma unroll
            for (int j = 0; j < 4; ++j) { x1[2 * j] = bf_lo(w1[st][j]); x1[2 * j + 1] = bf_hi(w1[st][j]); x2[2 * j] = bf_lo(w2[st][j]); x2[2 * j + 1] = bf_hi(w2[st][j]); }
            if (do_rms) {
                float s = 0.f;
#pragma unroll
                for (int j = 0; j < 8; ++j) s += x1[j] * x1[j] + x2[j] * x2[j];
                s += __shfl_xor(s, 1); s += __shfl_xor(s, 2);
                const float rinv = rsqrtf(s * (1.0f / 64.0f) + EPS);
                const f32x4 ga = *(const f32x4*)(gain + 8 * i), gb = *(const f32x4*)(gain + 8 * i + 4), gc = *(const f32x4*)(gain + 32 + 8 * i), gd = *(const f32x4*)(gain + 32 + 8 * i + 4);
#pragma unroll
                for (int j = 0; j < 4; ++j) { x1[j] *= rinv * ga[j]; x1[4 + j] *= rinv * gb[j]; x2[j] *= rinv * gc[j]; x2[4 + j] *= rinv * gd[j]; }
            }
            const float sc = is_q ? C2 : 1.0f;
            u32x4 o1, o2;
#pragma unroll
            for (int j = 0; j < 4; ++j) {
                float a0 = x1[2 * j], a1 = x1[2 * j + 1], b0 = x2[2 * j], b1 = x2[2 * j + 1];
                if (do_rope) { const float c0 = cv[2 * j], c1 = cv[2 * j + 1], s0 = sv[2 * j], s1 = sv[2 * j + 1];
                    const float ra0 = a0 * c0 - b0 * s0, ra1 = a1 * c1 - b1 * s1, rb0 = b0 * c0 + a0 * s0, rb1 = b1 * c1 + a1 * s1; a0 = ra0; a1 = ra1; b0 = rb0; b1 = rb1; }
                o1[j] = pk2(a0 * sc, a1 * sc); o2[j] = pk2(b0 * sc, b1 * sc);
            }
            *(u32x4*)(rp + head * 64 + 8 * i) = o1; *(u32x4*)(rp + head * 64 + 32 + 8 * i) = o2;
        }
    }
}

namespace att {
constexpr int KROW = 144;
constexpr int KBUF = 64 * KROW;
constexpr int VBUF = 128 * KROW;
constexpr int BUF = KBUF + VBUF;
struct Unit {
    const bf16* Q; int qpitch;
    const bf16* Kctx; const bf16* Klat; int kpitch;
    const bf16* VT;
    bf16* O; int opitch;
    int nctx, lat0, nlat;
    int qpos0;
    float sink2; int has_sink;
};
__device__ __forceinline__ void qk_tile(f32x16& p0, f32x16& p1, const LAS unsigned char* kb, int koff, const bf16x8 (&qf)[4], const f32x16& negm) {
    bf16x8 kf[8];
#pragma unroll
    for (int ds = 0; ds < 4; ++ds) { kf[2 * ds] = *(const LAS bf16x8*)(kb + koff + ds * 32); kf[2 * ds + 1] = *(const LAS bf16x8*)(kb + 32 * KROW + koff + ds * 32); }
    p0 = __builtin_amdgcn_mfma_f32_32x32x16_bf16(kf[0], qf[0], negm, 0, 0, 0);
    p1 = __builtin_amdgcn_mfma_f32_32x32x16_bf16(kf[1], qf[0], negm, 0, 0, 0);
#pragma unroll
    for (int ds = 1; ds < 4; ++ds) {
        p0 = __builtin_amdgcn_mfma_f32_32x32x16_bf16(kf[2 * ds], qf[ds], p0, 0, 0, 0);
        p1 = __builtin_amdgcn_mfma_f32_32x32x16_bf16(kf[2 * ds + 1], qf[ds], p1, 0, 0, 0);
    }
}
template <int NDB, bool PIPE>
__device__ __forceinline__ void softmax_pv(f32x16& p0, f32x16& p1, f32x16& pn0, f32x16& pn1, f32x16 (&o)[NDB], float& mref, float& l, f32x16& negm, bool first, const LAS unsigned char* vb, int voff) {
    bf16x8 vf[8];
#pragma unroll
    for (int i = 0; i < 8; ++i) vf[i] = *(const LAS bf16x8*)(vb + (32 * (i >> 2)) * KROW + voff + ((i >> 1) & 1) * 64 + (i & 1) * 32);
    float mx = __builtin_fmaxf(p0[0], p1[0]), mx2 = __builtin_fmaxf(p0[1], p1[1]);
#pragma unroll
    for (int r = 2; r < 16; r += 2) { mx = __builtin_fmaxf(__builtin_fmaxf(mx, p0[r]), p1[r]); mx2 = __builtin_fmaxf(__builtin_fmaxf(mx2, p0[r + 1]), p1[r + 1]); }
    mx = __builtin_fmaxf(mx, mx2);
    mx = fmaxf(mx, __shfl_xor(mx, 32));
    if (first || __any(mx > 8.0f)) { const float dl = first ? mx : fmaxf(mx, 0.f); mref += dl; const float f = first ? 1.0f : __builtin_amdgcn_exp2f(-dl); l *= f;
#pragma unroll
        for (int r = 0; r < 16; ++r) { p0[r] -= dl; p1[r] -= dl; if (PIPE) { pn0[r] -= dl; pn1[r] -= dl; } negm[r] = -mref; }
#pragma unroll
        for (int db = 0; db < NDB; ++db)
#pragma unroll
            for (int r = 0; r < 16; ++r) o[db][r] *= f; }
    float ls = 0.f;
#pragma unroll
    for (int r = 0; r < 16; ++r) { p0[r] = __builtin_amdgcn_exp2f(p0[r]); p1[r] = __builtin_amdgcn_exp2f(p1[r]); ls += p0[r] + p1[r]; }
    l += ls;
    bf16x8 pf[2][2];
#pragma unroll
    for (int s = 0; s < 2; ++s) {
        u32x4 w0, w1;
        w0.x = cvtpk_s(p0[8 * s + 0], p0[8 * s + 1]); w0.y = cvtpk_s(p0[8 * s + 2], p0[8 * s + 3]); w0.z = cvtpk_s(p0[8 * s + 4], p0[8 * s + 5]); w0.w = cvtpk_s(p0[8 * s + 6], p0[8 * s + 7]);
        w1.x = cvtpk_s(p1[8 * s + 0], p1[8 * s + 1]); w1.y = cvtpk_s(p1[8 * s + 2], p1[8 * s + 3]); w1.z = cvtpk_s(p1[8 * s + 4], p1[8 * s + 5]); w1.w = cvtpk_s(p1[8 * s + 6], p1[8 * s + 7]);
        pf[0][s] = __builtin_bit_cast(bf16x8, w0); pf[1][s] = __builtin_bit_cast(bf16x8, w1);
    }
#pragma unroll
    for (int blk = 0; blk < 2; ++blk)
#pragma unroll
        for (int s = 0; s < 2; ++s)
#pragma unroll
            for (int db = 0; db < NDB; ++db) {
                bf16x8 av; if (db < 2) av = vf[db * 4 + blk * 2 + s]; else av = *(const LAS bf16x8*)(vb + (32 * db) * KROW + voff + blk * 64 + s * 32);
                o[db] = __builtin_amdgcn_mfma_f32_32x32x16_bf16(av, pf[blk][s], o[db], 0, 0, 0);
            }
}
__device__ __forceinline__ void mask_tile(f32x16& p0, f32x16& p1, int kpos0, int qpos, int hi) {
    const unsigned base = (unsigned)(kpos0 + 8 * hi - qpos + 128);
#pragma unroll
    for (int r = 0; r < 16; ++r) { const unsigned t0 = base + (unsigned)(16 * (r >> 3) + (r & 7));
        if (t0 > 256u) p0[r] = -1e30f; if (t0 + 32u > 256u) p1[r] = -1e30f; }
}
constexpr int STASH0 = 57344;
template <int DV, bool WIN, bool DIFF>
__device__ __forceinline__ void unit(LAS unsigned char* lds, const Unit& U, int tid, int wid, int lane, float lam, float post, const float* subg) {
    constexpr int NDB = DV / 32, NVL = DV / 64, VB0 = 2 * KBUF;
    asm volatile("" : "+v"(tid)); lane = tid & 63;
    const int r32 = lane & 31, hi = lane >> 5;
    const int nt = U.nctx + U.nlat;
    const int lrow = tid >> 3, lch = tid & 7;
    const int krow = (r32 & ~12) | ((r32 & 4) << 1) | ((r32 & 8) >> 1);
    const int koff = krow * KROW + hi * 16, voff = r32 * KROW + hi * 16;
    const int qw0 = U.qpos0 + wid * 32, qpos = qw0 + r32;
    const unsigned lkoff = (unsigned)(lrow * U.kpitch + (lch & 3) * 8 + (lch >> 2) * 128) * 2u, lvoff = (unsigned)(lrow * NKEY + lch * 8) * 2u;
    const unsigned lsoff = (unsigned)(lrow * KROW + lch * 16);
    LAS unsigned* stash = (LAS unsigned*)(lds + STASH0 + wid * 8192) + lane;
#pragma unroll 1
    for (int cmap = 0; cmap < (DIFF ? 2 : 1); ++cmap) {
    const int coff = cmap * 32;
    bf16x8 qf[4];
    { const bf16* qp = U.Q + coff + (size_t)(wid * 32 + r32) * U.qpitch + hi * 8;
#pragma unroll
      for (int ds = 0; ds < 4; ++ds) qf[ds] = *(const bf16x8*)(qp + (ds & 1) * 16 + (ds >> 1) * 128); }
    f32x16 o[NDB];
#pragma unroll
    for (int db = 0; db < NDB; ++db)
#pragma unroll
        for (int r = 0; r < 16; ++r) o[db][r] = 0.f;
    float mref = 0.f, l = 0.f; f32x16 negm, p0, p1;
#pragma unroll
    for (int r = 0; r < 16; ++r) negm[r] = 0.f;
    u32x4 kregA, vregA[NVL], kregB, vregB[NVL];
#define ATT_LOAD(KR, VR, t) do { const int t_ = (t); const bf16* kp_ = (t_ < U.nctx ? U.Kctx + (size_t)(t_ * 64) * U.kpitch : U.Klat + (size_t)(U.lat0 + (t_ - U.nctx) * 64) * U.kpitch) + coff; \
        KR = *(const u32x4*)((const char*)kp_ + lkoff); const int kidx_ = t_ < U.nctx ? t_ * 64 : CTX + U.lat0 + (t_ - U.nctx) * 64; const bf16* vp_ = U.VT + kidx_; \
        _Pragma("unroll") for (int v_ = 0; v_ < NVL; ++v_) VR[v_] = *(const u32x4*)((const char*)vp_ + lvoff + (unsigned)(v_ * 64 * NKEY * 2)); } while (0)
#define ATT_STORE(KR, VR, buf) do { *(LAS u32x4*)(lds + (buf) * KBUF + lsoff) = KR; \
        _Pragma("unroll") for (int v_ = 0; v_ < NVL; ++v_) *(LAS u32x4*)(lds + VB0 + (buf) * VBUF + v_ * 64 * KROW + lsoff) = VR[v_]; } while (0)
#define ATT_KPOS(t) (U.lat0 + ((t) - U.nctx) * 64)
#define ATT_SKIP(t) (WIN && (t) >= U.nctx && (ATT_KPOS(t) > qw0 + 31 + 128 || ATT_KPOS(t) + 63 < qw0 - 128))
#define ATT_STEP(KL, VL, KS, VS, tt) do { const int t_s = (tt); \
        if (t_s + 2 < nt) ATT_LOAD(KL, VL, t_s + 2); \
        if (!ATT_SKIP(t_s)) { qk_tile(p0, p1, lds + (t_s & 1) * KBUF, koff, qf, negm); \
            if (WIN) { if (t_s >= U.nctx && !(ATT_KPOS(t_s) >= qw0 - 97 && ATT_KPOS(t_s) + 63 <= qw0 + 128)) mask_tile(p0, p1, ATT_KPOS(t_s), qpos, hi); }     \
            softmax_pv<NDB, false>(p0, p1, p0, p1, o, mref, l, negm, t_s == 0, lds + VB0 + (t_s & 1) * VBUF, voff); } \
        if (t_s + 1 < nt) ATT_STORE(KS, VS, (t_s + 1) & 1); \
        __syncthreads(); } while (0)
    ATT_LOAD(kregA, vregA, 0); ATT_STORE(kregA, vregA, 0);
    if (nt > 1) ATT_LOAD(kregB, vregB, 1);
    __syncthreads();
    for (int t = 0; t < nt; t += 2) {
        ATT_STEP(kregA, vregA, kregB, vregB, t);
        if (t + 1 < nt) ATT_STEP(kregB, vregB, kregA, vregA, t + 1);
    }
#undef ATT_LOAD
#undef ATT_STORE
#undef ATT_KPOS
#undef ATT_SKIP
#undef ATT_STEP
    l += __shfl_xor(l, 32);
    if (U.has_sink) l += __builtin_amdgcn_exp2f(U.sink2 - mref);
    const float inv = 1.0f / l;
    if (DIFF) {
        if (cmap == 0) {
#pragma unroll
            for (int db = 0; db < NDB; ++db)
#pragma unroll
                for (int k = 0; k < 8; ++k) stash[(db * 8 + k) * 64] = pk2(o[db][2 * k] * inv, o[db][2 * k + 1] * inv);
        } else {
            float ss = 0.f;
#pragma unroll
            for (int db = 0; db < NDB; ++db)
#pragma unroll
                for (int k = 0; k < 8; ++k) { const unsigned w = stash[(db * 8 + k) * 64];
                    o[db][2 * k] = bf_lo(w) - lam * (o[db][2 * k] * inv); o[db][2 * k + 1] = bf_hi(w) - lam * (o[db][2 * k + 1] * inv);
                    ss += o[db][2 * k] * o[db][2 * k] + o[db][2 * k + 1] * o[db][2 * k + 1]; }
            ss += __shfl_xor(ss, 32);
            const float rinv = rsqrtf(ss * (1.0f / 128.0f) + EPS) * post;
            bf16* op = U.O + (size_t)(wid * 32 + r32) * U.opitch + 4 * hi;
#pragma unroll
            for (int db = 0; db < NDB; ++db)
#pragma unroll
                for (int g = 0; g < 4; ++g) { const f32x4 sg = *(const f32x4*)(subg + 32 * db + 8 * g + 4 * hi);
                    u32x2 w; w.x = pk2(o[db][4 * g] * rinv * sg[0], o[db][4 * g + 1] * rinv * sg[1]); w.y = pk2(o[db][4 * g + 2] * rinv * sg[2], o[db][4 * g + 3] * rinv * sg[3]);
                    *(u32x2*)(op + 32 * db + 8 * g) = w; }
        }
    } else {
        bf16* op = U.O + (size_t)(wid * 32 + r32) * U.opitch + 4 * hi;
#pragma unroll
        for (int db = 0; db < NDB; ++db)
#pragma unroll
            for (int g = 0; g < 4; ++g) { u32x2 w; w.x = pk2(o[db][4 * g] * inv, o[db][4 * g + 1] * inv); w.y = pk2(o[db][4 * g + 2] * inv, o[db][4 * g + 3] * inv);
                *(u32x2*)(op + 32 * db + 8 * g) = w; }
    }
    }
}
template <bool WIN>
__device__ __forceinline__ void unit2(LAS unsigned char* lds, const Unit& U, int tid, int wid, int lane) {
    constexpr int NDB = 2, VB0 = 4 * KBUF;
    asm volatile("" : "+v"(tid)); lane = tid & 63;
    const int r32 = lane & 31, hi = lane >> 5;
    const int nt = U.nctx + U.nlat, ns = (nt + 1) >> 1;
    const int lrow = tid >> 3, lch = tid & 7;
    const int krow = (r32 & ~12) | ((r32 & 4) << 1) | ((r32 & 8) >> 1);
    const int koff = krow * KROW + hi * 16, voff = r32 * KROW + hi * 16;
    const int qw0 = U.qpos0 + wid * 32, qpos = qw0 + r32;
    const unsigned lkoff = (unsigned)(lrow * U.kpitch + (lch & 3) * 8 + (lch >> 2) * 128) * 2u, lvoff = (unsigned)(lrow * NKEY + lch * 8) * 2u;
    const unsigned lsoff = (unsigned)(lrow * KROW + lch * 16);
    bf16x8 qf[4];
    { const bf16* qp = U.Q + (size_t)(wid * 32 + r32) * U.qpitch + hi * 8;
#pragma unroll
      for (int ds = 0; ds < 4; ++ds) qf[ds] = *(const bf16x8*)(qp + (ds & 1) * 16 + (ds >> 1) * 128); }
    f32x16 o[NDB];
#pragma unroll
    for (int db = 0; db < NDB; ++db)
#pragma unroll
        for (int r = 0; r < 16; ++r) o[db][r] = 0.f;
    float mref = 0.f, l = 0.f; f32x16 negm, p0, p1;
#pragma unroll
    for (int r = 0; r < 16; ++r) negm[r] = 0.f;
    u32x4 kA[2], vA[2], kB[2], vB[2];
#define U2_LOAD(KR, VR, s) do { _Pragma("unroll") for (int j_ = 0; j_ < 2; ++j_) { const int t_ = 2 * (s) + j_; if (t_ < nt) { \
        const bf16* kp_ = t_ < U.nctx ? U.Kctx + (size_t)(t_ * 64) * U.kpitch : U.Klat + (size_t)(U.lat0 + (t_ - U.nctx) * 64) * U.kpitch; \
        KR[j_] = *(const u32x4*)((const char*)kp_ + lkoff); const int kidx_ = t_ < U.nctx ? t_ * 64 : CTX + U.lat0 + (t_ - U.nctx) * 64; \
        VR[j_] = *(const u32x4*)((const char*)(U.VT + kidx_) + lvoff); } } } while (0)
#define U2_STORE(KR, VR, buf) do { _Pragma("unroll") for (int j_ = 0; j_ < 2; ++j_) { *(LAS u32x4*)(lds + ((buf) * 2 + j_) * KBUF + lsoff) = KR[j_]; *(LAS u32x4*)(lds + VB0 + ((buf) * 2 + j_) * KBUF + lsoff) = VR[j_]; } } while (0)
#define U2_KPOS(t) (U.lat0 + ((t) - U.nctx) * 64)
#define U2_SKIP(t) (WIN && (t) >= U.nctx && (U2_KPOS(t) > qw0 + 31 + 128 || U2_KPOS(t) + 63 < qw0 - 128))
#define U2_STEP(KL, VL, KS, VS, ss) do { const int s_ = (ss); \
        if (s_ + 2 < ns) U2_LOAD(KL, VL, s_ + 2); \
        _Pragma("unroll") for (int j2_ = 0; j2_ < 2; ++j2_) { const int t_s = 2 * s_ + j2_; \
            if (t_s < nt && !U2_SKIP(t_s)) { qk_tile(p0, p1, lds + ((s_ & 1) * 2 + j2_) * KBUF, koff, qf, negm); \
                if (WIN) { if (t_s >= U.nctx && !(U2_KPOS(t_s) >= qw0 - 97 && U2_KPOS(t_s) + 63 <= qw0 + 128)) mask_tile(p0, p1, U2_KPOS(t_s), qpos, hi); } \
                softmax_pv<NDB, false>(p0, p1, p0, p1, o, mref, l, negm, t_s == 0, lds + VB0 + ((s_ & 1) * 2 + j2_) * KBUF, voff); } } \
        if (s_ + 1 < ns) U2_STORE(KS, VS, (s_ + 1) & 1); \
        __syncthreads(); } while (0)
    U2_LOAD(kA, vA, 0); U2_STORE(kA, vA, 0);
    if (ns > 1) U2_LOAD(kB, vB, 1);
    __syncthreads();
    for (int s = 0; s < ns; s += 2) {
        U2_STEP(kA, vA, kB, vB, s);
        if (s + 1 < ns) U2_STEP(kB, vB, kA, vA, s + 1);
    }
#undef U2_LOAD
#undef U2_STORE
#undef U2_KPOS
#undef U2_SKIP
#undef U2_STEP
    l += __shfl_xor(l, 32);
    if (U.has_sink) l += __builtin_amdgcn_exp2f(U.sink2 - mref);
    const float inv = 1.0f / l;
    bf16* op = U.O + (size_t)(wid * 32 + r32) * U.opitch + 4 * hi;
#pragma unroll
    for (int db = 0; db < NDB; ++db)
#pragma unroll
        for (int g = 0; g < 4; ++g) { u32x2 w; w.x = pk2(o[db][4 * g] * inv, o[db][4 * g + 1] * inv); w.y = pk2(o[db][4 * g + 2] * inv, o[db][4 * g + 3] * inv);
            *(u32x2*)(op + 32 * db + 8 * g) = w; }
}
}

__device__ __forceinline__ void combine_pass(const bf16* OB, bf16* o, const float* lq1, const float* lk1, const float* lq2, const float* lk2, const float* subg, float lam_init, int gw, int NGW, int lane) {
    const float s1 = wave_sum(lq1[lane] * lk1[lane]), s2 = wave_sum(lq2[lane] * lk2[lane]);
    const float lam = __builtin_amdgcn_exp2f(s1 * LOG2E) - __builtin_amdgcn_exp2f(s2 * LOG2E) + lam_init;
    const int h = lane >> 4, e0 = (lane & 15) * 8;
    float g[8];
#pragma unroll
    for (int j = 0; j < 8; ++j) g[j] = subg[e0 + j] * (1.0f - lam_init);
    for (int row = gw; row < T; row += NGW) {
        const u32x4 a = *(const u32x4*)(OB + (size_t)row * D + (2 * h) * 128 + e0), b = *(const u32x4*)(OB + (size_t)row * D + (2 * h + 1) * 128 + e0);
        float d[8];
        d[0] = bf_lo(a.x) - lam * bf_lo(b.x); d[1] = bf_hi(a.x) - lam * bf_hi(b.x); d[2] = bf_lo(a.y) - lam * bf_lo(b.y); d[3] = bf_hi(a.y) - lam * bf_hi(b.y);
        d[4] = bf_lo(a.z) - lam * bf_lo(b.z); d[5] = bf_hi(a.z) - lam * bf_hi(b.z); d[6] = bf_lo(a.w) - lam * bf_lo(b.w); d[7] = bf_hi(a.w) - lam * bf_hi(b.w);
        float s = 0.f;
#pragma unroll
        for (int j = 0; j < 8; ++j) s += d[j] * d[j];
        s += __shfl_xor(s, 1); s += __shfl_xor(s, 2); s += __shfl_xor(s, 4); s += __shfl_xor(s, 8);
        const float rinv = rsqrtf(s * (1.0f / 128.0f) + EPS);
        u32x4 w; w.x = pk2(d[0] * rinv * g[0], d[1] * rinv * g[1]); w.y = pk2(d[2] * rinv * g[2], d[3] * rinv * g[3]); w.z = pk2(d[4] * rinv * g[4], d[5] * rinv * g[5]); w.w = pk2(d[6] * rinv * g[6], d[7] * rinv * g[7]);
        *(u32x4*)(o + (size_t)row * D + 512 + h * 128 + e0) = w;
    }
}

#define XB_TMO      128
#define XB_XCNT(j)  (256  + 64 * (j))
#define XB_XSUB(j)  (1280 + 64 * (j))
#define XB_XGEN(j)  (2304 + 64 * (j))
#define XB_TOP      3328
#define XB_TOPGEN   3392
#define XCD_BAR_WORDS 3456
#define XB_SPIN_CAP (1u << 18)

__device__ __forceinline__ unsigned xb_ld(unsigned* p)              { return __hip_atomic_load(p, __ATOMIC_RELAXED, __HIP_MEMORY_SCOPE_AGENT); }
__device__ __forceinline__ unsigned xb_add(unsigned* p, unsigned v) { return __hip_atomic_fetch_add(p, v, __ATOMIC_RELAXED, __HIP_MEMORY_SCOPE_AGENT); }
__device__ __forceinline__ unsigned xb_xcc_id() { return (unsigned)__builtin_amdgcn_s_getreg((3 << 11) | 20) & 0xFu; }
#define XB_SPIN(cond, bar) do { unsigned _sp = 0; while (cond) { __builtin_amdgcn_s_sleep(1); \
    if ((++_sp & 255u) == 0u) { if (xb_ld(&(bar)[XB_TMO])) break; if (_sp > XB_SPIN_CAP) { atomicAdd(&(bar)[XB_TMO], 1u); break; } } } } while (0)

struct XcdBarrier {
    unsigned* bar; unsigned x;
    volatile LAS unsigned* st;
};

__device__ __forceinline__ XcdBarrier xcd_barrier_post(unsigned* bar, volatile LAS unsigned* st) {
    XcdBarrier b; b.bar = bar; b.x = xb_xcc_id(); b.st = st;
    if (threadIdx.x == 0) (void)xb_add(&bar[XB_XCNT(b.x)], 1u);
    return b;
}
__device__ __forceinline__ void xcd_barrier_complete(unsigned* bar, unsigned x, unsigned& nloc, unsigned& nx) {
    const unsigned G = gridDim.x * gridDim.y * gridDim.z;
    unsigned sum, cnt, mine, sp = 0u;
    for (;;) {
        sum = 0u; cnt = 0u; mine = 0u;
#pragma unroll
        for (unsigned j = 0; j < 16; ++j) { const unsigned c = xb_ld(&bar[XB_XCNT(j)]); sum += c; cnt += (c > 0u) ? 1u : 0u; mine = (j == x) ? c : mine; }
        if (sum == G) break;
        __builtin_amdgcn_s_sleep(1);
        if ((++sp & 255u) == 0u) { if (xb_ld(&bar[XB_TMO])) break; if (sp > XB_SPIN_CAP) { atomicAdd(&bar[XB_TMO], 1u); break; } }
    }
    nloc = mine > 0u ? mine : 1u; nx = cnt > 0u ? cnt : 1u;
}

__device__ __forceinline__ void xcd_barrier(const XcdBarrier& b) {
    asm volatile("s_waitcnt vmcnt(0)" ::: "memory");
    __syncthreads();
    if (threadIdx.x == 0) {
        unsigned* bar = b.bar;
        __builtin_amdgcn_s_waitcnt(0);
        unsigned nloc = b.st[0], nx = b.st[1];
        if (nloc == 0u) { xcd_barrier_complete(bar, b.x, nloc, nx); b.st[0] = nloc; b.st[1] = nx; }
        const unsigned old = xb_add(&bar[XB_XSUB(b.x)], 1u);
        const unsigned gen = old / nloc;
        if (old + 1u == (gen + 1u) * nloc) {
            __builtin_amdgcn_fence(__ATOMIC_RELEASE, "agent");
            asm volatile("s_waitcnt vmcnt(0)" ::: "memory");
            const unsigned og = xb_add(&bar[XB_TOP], 1u);
            const unsigned tg = og / nx;
            if (og + 1u == (tg + 1u) * nx) xb_add(&bar[XB_TOPGEN], 1u);
            else XB_SPIN(xb_ld(&bar[XB_TOPGEN]) == tg, bar);
            __builtin_amdgcn_fence(__ATOMIC_ACQUIRE, "agent");
            xb_add(&bar[XB_XGEN(b.x)], 1u);
            asm volatile("s_waitcnt vmcnt(0)" ::: "memory");
        } else {
            XB_SPIN(xb_ld(&bar[XB_XGEN(b.x)]) == gen, bar);
            __builtin_amdgcn_fence(__ATOMIC_ACQUIRE, "agent");
            asm volatile("s_waitcnt vmcnt(0)" ::: "memory");
        }
    }
    __syncthreads();
}

#define HB(H) (256 * ((H) >> 2) + 32 * ((H) & 3))
constexpr int NPHASE = 26;
__global__ void __launch_bounds__(512, 2) mega(Args args) {
    extern __shared__ __attribute__((aligned(16))) unsigned char lds_raw[];
    LAS unsigned char* lds = (LAS unsigned char*)lds_raw;
    cg::grid_group grid = cg::this_grid();
    if (args.ph_lo < 0) grid.sync();
    volatile LAS unsigned* misc = (volatile LAS unsigned*)(lds + RING_BYTES);
    if (threadIdx.x < 64) misc[threadIdx.x] = 0u;
    __syncthreads();
    XcdBarrier bar = xcd_barrier_post(as_global((unsigned*)args.ws) + 1024, misc + 8);

#ifndef MK_REPMASK
#define MK_REPMASK 0
#endif
#ifdef MK_EXTRA_SYNCS
    for (int i = 0; i < MK_EXTRA_SYNCS; ++i) xcd_barrier(bar);
#endif
    for (int ph = args.ph_lo, rep = 0; ph < args.ph_hi; ) {
        if (ph >= 2 && ((ph - 2) % 12 == 6 || (ph - 2) % 12 == 4)) { ++ph; continue; }
        int tid = threadIdx.x; asm volatile("" : "+v"(tid));
        int bx = blockIdx.x; asm volatile("" : "+s"(bx));
        unsigned char* ws; { unsigned long long wi = (unsigned long long)args.ws; unsigned wlo = __builtin_amdgcn_readfirstlane((unsigned)wi), whi = __builtin_amdgcn_readfirstlane((unsigned)(wi >> 32)); asm volatile("" : "+s"(wlo), "+s"(whi)); wi = ((unsigned long long)whi << 32) | wlo; ws = (unsigned char*)(__attribute__((address_space(1))) unsigned char*)wi; }
        const int lane = tid & 63, wave = __builtin_amdgcn_readfirstlane(tid >> 6);
        const int G = gridDim.x;
        const int gw = bx * NWAVES + wave, NGW = G * NWAVES;
        float* mod = (float*)(ws + WS_MOD);
        const float* cs = (const float*)(ws + WS_ROPE); const float* sn = cs + SEQ * 32;
        float* part = (float*)(ws + WS_PART);
        float* xctx = (float*)(ws + WS_XCTX);
        bf16* hbuf = (bf16*)(ws + WS_H); bf16* ybuf = (bf16*)(ws + WS_Y); bf16* actbuf = (bf16*)(ws + WS_ACT); bf16* vtbuf = (bf16*)(ws + WS_VT);
        if (ph == 0) {
#ifndef NO_PRO
            prologue(args, lds, gw, NGW, wave, lane, tid, G);
#endif
        } else if (ph == 1) {
            ResidParams P; P.xsrc_lat = as_global(args.in[I_X]); P.xsrc_ctx = as_global(args.in[I_CTX]); P.xdst_lat = as_global(args.out); P.xdst_ctx = xctx; P.y = nullptr; P.part = nullptr; P.h = hbuf;
            P.gate = nullptr; P.gpost = nullptr; P.shift = mod; P.scale = mod + 1024; P.gpre = as_global(args.in[I_GPRE]); P.res_w = 0.f; P.nrows = T; P.has_y = 0; P.has_h = 1; P.write_x = 0; P.row_lo = 0;
            resid_pass(P, gw, NGW, lane);
        } else {
            const int L = (ph - 2) / 12, q = (ph - 2) % 12;
            const int Mrows = (L == 1 && q >= 5) ? TLAT : T;
            if (q == 0 || q == 9) {
                const int s = q == 0 ? 0 : 1;
                pg8::Gemm g{hbuf, (const bf16*)(ws + WS_WGU + (size_t)(2 * L + s) * WGU_BYTES), Mrows, 2 * FF, D}; pg8::StaticOrder S; S.init(Mrows, 2 * FF, G, bx);
                pg8::EpiSwiGLU E{actbuf, FF};
                pg8::gemm_phase<pg8::EpiSwiGLU, pg8::StaticOrder, true, true>(lds, g, S, E, tid);
            } else if (q == 1 || q == 7 || q == 10) {
                pg8::Gemm g;
                if (q == 7) g = pg8::Gemm{hbuf, (const bf16*)(ws + (L == 0 ? WS_WOUT0 : WS_WOUTC)), TLAT, D, D};
                else g = pg8::Gemm{actbuf, (const bf16*)(ws + WS_WD + (size_t)(2 * L + (q == 1 ? 0 : 1)) * WD_BYTES), TLAT, D, FF};
                pg8::StaticOrder S; S.init(TLAT, D, G, bx);
                pg8::EpiY E{ybuf, D, part};
                pg8::gemm_phase<pg8::EpiY, pg8::StaticOrder, true, true>(lds, g, S, E, tid);
            } else if (q == 2 || q == 8 || q == 11) {
                const int sub = q == 2 ? 0 : (q == 8 ? 1 : 2);
                const bool fin = (L == 1 && q == 11);
                const int Ln = q == 11 ? L + 1 : L, subn = q == 11 ? 0 : sub + 1;
                ResidParams P; P.xsrc_lat = as_global(args.out); P.xsrc_ctx = xctx; P.xdst_lat = as_global(args.out); P.xdst_ctx = xctx; P.y = ybuf; P.part = part; P.h = hbuf;
                if (L == 0 && q == 2) { P.xsrc_lat = as_global(args.in[I_X]); P.xsrc_ctx = as_global(args.in[I_CTX]); }
                P.gate = mod + (size_t)L * 17 * NMOD + sub * 3072 + 2048; P.gpost = as_global(args.in[I_GPOST]) + (L * 3 + sub) * D;
                P.shift = fin ? mod : mod + (size_t)Ln * 17 * NMOD + subn * 3072; P.scale = P.shift + 1024; P.gpre = fin ? as_global(args.in[I_GPRE]) : as_global(args.in[I_GPRE]) + (Ln * 3 + subn) * D;
                P.res_w = (q == 8) ? 1.0f : 0.5f; P.has_y = 1; P.has_h = fin ? 0 : 1; P.write_x = 1;
                const bool split = (Mrows == T) && G > 64;
                if (!split) { P.row_lo = 0; P.nrows = Mrows; resid_pass(P, gw, NGW, lane); }
                else if (bx >= 64) {
                    P.row_lo = 0; P.nrows = TLAT; resid_pass(P, (bx - 64) * NWAVES + wave, (G - 64) * NWAVES, lane);
                } else {
                    pg8::Gemm g;
                    if (q == 8) g = pg8::Gemm{hbuf + (size_t)TLAT * D, (const bf16*)(ws + (L == 0 ? WS_WOUT0 : WS_WOUTC)), TCTX, D, D};
                    else g = pg8::Gemm{actbuf + (size_t)TLAT * FF, (const bf16*)(ws + WS_WD + (size_t)(2 * L + (q == 2 ? 0 : 1)) * WD_BYTES), TCTX, D, FF};
                    pg8::StaticOrder S; S.init(TCTX, D, 64, bx);
                    pg8::EpiY E{ybuf + (size_t)TLAT * D, D, part + (size_t)TLAT * 16};
                    pg8::gemm_phase<pg8::EpiY, pg8::StaticOrder, true, true>(lds, g, S, E, tid);
                    pg8::Unit u; (void)S.next(0, u);
                    unsigned* cnt = as_global((unsigned*)args.ws) + 8192 + ((L * 3 + (q == 2 ? 0 : (q == 8 ? 1 : 2))) * 16 + u.pm) * 64;
                    asm volatile("s_waitcnt vmcnt(0)" ::: "memory"); __syncthreads();
                    if (threadIdx.x == 0) {
                        __builtin_amdgcn_fence(__ATOMIC_RELEASE, "agent"); asm volatile("s_waitcnt vmcnt(0)" ::: "memory");
                        (void)__hip_atomic_fetch_add(cnt, 1u, __ATOMIC_RELAXED, __HIP_MEMORY_SCOPE_AGENT);
                        unsigned sp = 0; while (__hip_atomic_load(cnt, __ATOMIC_RELAXED, __HIP_MEMORY_SCOPE_AGENT) < 4u && ++sp < (1u << 22)) __builtin_amdgcn_s_sleep(2);
                        __builtin_amdgcn_fence(__ATOMIC_ACQUIRE, "agent"); asm volatile("s_waitcnt vmcnt(0)" ::: "memory");
                    }
                    __syncthreads();
                    int tid3 = threadIdx.x; asm volatile("" : "+v"(tid3));
                    P.row_lo = TLAT + u.pm * 256 + u.pn * 64; P.nrows = 64; if (L == 1) P.write_x = 0;
                    resid_pass(P, wave, NWAVES, tid3 & 63);
                }
            } else if (q == 3) {
                { pg8::Gemm g{hbuf, (const bf16*)(ws + (L == 0 ? WS_WQK0 : WS_WINC)), T, L == 0 ? PQK0 : PQK1, D}; pg8::StaticOrder S; S.init(g.M, g.N, G, bx); S.wgm = 8;
                  pg8::EpiQK E{actbuf, L == 0 ? PQK0 : PQK1, L, cs, sn, as_global(args.in[I_QGAIN]), as_global(args.in[I_KGAIN]), TLAT, C2};
                  pg8::gemm_phase<pg8::EpiQK, pg8::StaticOrder, true, true>(lds, g, S, E, tid); }
                __syncthreads();
                int tidb = threadIdx.x; asm volatile("" : "+v"(tidb));
                { pg8::Gemm g{(const bf16*)(ws + (L == 0 ? WS_WV0 : WS_WINC + (size_t)1280 * D * 2)), hbuf, L == 0 ? NVR0 : NVR1, T, D}; pg8::StaticOrder S; S.init(g.M, g.N, G, bx);
                  pg8::EpiVT E{vtbuf, L == 0 ? NVR0 : NVR1};
                  pg8::gemm_phase<pg8::EpiVT, pg8::StaticOrder, true, true>(lds, g, S, E, tidb); }
            } else if (q == 4) {
                qk_pass(actbuf, L, as_global(args.in[I_QGAIN]), as_global(args.in[I_KGAIN]), cs, sn, gw, NGW, lane);
            } else if (q == 5) {
#ifndef NO_ATT
                if (L == 0) {
                    float lam; { const float s1 = wave_sum(as_global(args.in[I_LQ1])[lane] * as_global(args.in[I_LK1])[lane]), s2 = wave_sum(as_global(args.in[I_LQ2])[lane] * as_global(args.in[I_LK2])[lane]);
                        lam = __builtin_amdgcn_exp2f(s1 * LOG2E) - __builtin_amdgcn_exp2f(s2 * LOG2E) + 0.2f; }
                    for (int vbx = bx; vbx < 256; vbx += G)
                    for (int k = 0; k < 7; ++k) {
                        const int x = vbx & 7, j = vbx >> 3;
                        att::Unit U; U.qpitch = PQK0; U.kpitch = PQK0; U.opitch = D; U.has_sink = 0; U.sink2 = 0.f; U.qpos0 = 0; U.lat0 = 0; U.nctx = 4;
                        int b, hh, qrow; bool isB;
                        if (k < 2) { const int pidx = (k * 8 + x) * 4 + (j >> 3); b = pidx >> 2; hh = pidx & 3; qrow = b * SEQ + (j & 7) * 256; U.nlat = 32; isB = true; }
                        else if (k < 6) { const int idx = (k - 2) * 8 + x; b = idx >> 1; hh = (idx & 1) * 4 + (j >> 3); qrow = b * SEQ + (j & 7) * 256; U.nlat = 32; isB = false; }
                        else { if (vbx >= 192) continue; U.nlat = 0;
                            if (vbx < 64) { b = vbx >> 2; hh = vbx & 3; isB = true; } else { const int v = vbx - 64; b = v >> 3; hh = v & 7; isB = false; }
                            qrow = TLAT + b * CTX; }
                        const size_t krow0 = (size_t)(TLAT + b * CTX) * PQK0, krow1 = (size_t)(b * SEQ) * PQK0;
                        if (isB) {
                            U.Q = actbuf + (size_t)qrow * PQK0 + HB(10 + 2 * hh); U.Kctx = actbuf + krow0 + HB(18 + 2 * hh); U.Klat = actbuf + krow1 + HB(18 + 2 * hh);
                            U.VT = vtbuf + ((size_t)b * NVR0 + 128 + hh * 128) * NKEY; U.O = hbuf + (size_t)qrow * D + 512 + hh * 128;
                            att::unit<128, false, true>(lds, U, tid, wave, lane, lam, 0.8f, as_global(args.in[I_SUBG]));
                        } else {
                            U.Q = actbuf + (size_t)qrow * PQK0 + HB(hh); U.Kctx = actbuf + krow0 + HB(8 + (hh >> 2)); U.Klat = actbuf + krow1 + HB(8 + (hh >> 2));
                            U.VT = vtbuf + ((size_t)b * NVR0 + (hh >> 2) * 64) * NKEY; U.O = hbuf + (size_t)qrow * D + hh * 64;
                            att::unit<64, false, false>(lds, U, tid, wave, lane, 0.f, 0.f, nullptr);
                        }
                    }
                } else {
                    for (int vbx = bx; vbx < 256; vbx += G)
                    for (int k = 0; k < 8; ++k) {
                        const int x = vbx & 7, j = vbx >> 3, idx = k * 8 + x; const int b = idx >> 2, hh = (idx & 3) * 4 + (j >> 3), qb = (j + k) & 7; const int q0 = qb * 256, qrow = b * SEQ + q0;
                        const int s0 = q0 - 128 < 0 ? 0 : q0 - 128, s1 = q0 + 384 > SEQ ? SEQ : q0 + 384;
                        att::Unit U; U.qpitch = PQK1; U.kpitch = PQK1; U.opitch = D; U.has_sink = 1; U.sink2 = as_global(args.in[I_SINK])[hh] * LOG2E; U.qpos0 = q0; U.lat0 = s0; U.nctx = 4; U.nlat = (s1 - s0) >> 6;
                        U.Q = actbuf + (size_t)qrow * PQK1 + HB(hh); U.Kctx = actbuf + (size_t)(TLAT + b * CTX) * PQK1 + HB(16 + (hh >> 2)); U.Klat = actbuf + (size_t)(b * SEQ) * PQK1 + HB(16 + (hh >> 2));
                        U.VT = vtbuf + ((size_t)b * NVR1 + (hh >> 2) * 64) * NKEY; U.O = hbuf + (size_t)qrow * D + hh * 64;
                        att::unit2<true>(lds, U, tid, wave, lane);
                    }
                }
#endif
            } else if (q == 6) {
                if (false) combine_pass(ybuf, hbuf, as_global(args.in[I_LQ1]), as_global(args.in[I_LK1]), as_global(args.in[I_LQ2]), as_global(args.in[I_LK2]), as_global(args.in[I_SUBG]), 0.2f, gw, NGW, lane);
            }
        }
        if (ph + 1 < args.ph_hi) xcd_barrier(bar);
        if (MK_REPMASK != 0 && rep == 0 && ((ph >= 2 && ((MK_REPMASK >> ((ph - 2) % 12)) & 1)) || (ph == 0 && (MK_REPMASK & 0x10000)))) rep = 1; else { rep = 0; ++ph; }
    }
}


#ifdef MK_DUMP
__global__ void dump_k(const unsigned short* a, const unsigned short* b, float* out, size_t n) {
    for (size_t i = (size_t)blockIdx.x * blockDim.x + threadIdx.x; i < n; i += (size_t)gridDim.x * blockDim.x) {
        float v = __builtin_bit_cast(float, (unsigned)a[i] << 16); if (b) v += __builtin_bit_cast(float, (unsigned)b[i] << 16); out[i] = v; }
}
#endif
#ifndef MK_ONE_LAUNCH
#define MK_ONE_LAUNCH 1
#endif
extern "C" void kernel_launch(void* const* d_in, const int* in_sizes, int n_in, void* d_out, int out_size, void* d_ws, size_t ws_size, hipStream_t stream) {
    static int grid = 0;
    if (grid == 0) {
        if (n_in != 23 || ws_size < WS_END || out_size != TLAT * D) { fprintf(stderr, "kernel_launch: unexpected shapes (n_in %d, ws %zu, out %d); nothing launched\n", n_in, ws_size, out_size); grid = -1; return; }
        int dev = 0, cus = 0, per_cu = 0;
        (void)hipGetDevice(&dev); (void)hipDeviceGetAttribute(&cus, hipDeviceAttributeMultiprocessorCount, dev);
        if (hipFuncSetAttribute((const void*)mega, hipFuncAttributeMaxDynamicSharedMemorySize, LDS_BYTES) != hipSuccess) { fprintf(stderr, "kernel_launch: hipFuncSetAttribute failed\n"); grid = -1; return; }
        if (hipOccupancyMaxActiveBlocksPerMultiprocessor(&per_cu, (const void*)mega, 512, LDS_BYTES) != hipSuccess || per_cu < 1) { fprintf(stderr, "kernel_launch: occupancy query says %d\n", per_cu); per_cu = 1; }
        (void)hipGetLastError();
        grid = cus;
    }
    if (grid < 0) return;
    if (hipMemsetAsync(d_ws, 0, 65536, stream) != hipSuccess) { fprintf(stderr, "kernel_launch: memset of the barrier words failed\n"); return; }
    Args a{};
    for (int i = 0; i < 23; ++i) a.in[i] = (const float*)d_in[i];
    a.out = (float*)d_out; a.ws = (unsigned char*)d_ws;
#if MK_ONE_LAUNCH
    a.ph_lo = 0; a.ph_hi = NPHASE;
    void* kargs[] = {&a};
    hipError_t e = hipLaunchCooperativeKernel((const void*)mega, dim3(grid), dim3(512), kargs, LDS_BYTES, stream);
    if (e != hipSuccess) fprintf(stderr, "kernel_launch: cooperative launch failed: %s (grid %d)\n", hipGetErrorString(e), grid);
#else
#ifndef MK_STOP_PH
#define MK_STOP_PH NPHASE
#endif
    for (int ph = 0; ph < MK_STOP_PH; ++ph) {
        if (ph == 2 + 12 + 6) continue;
        a.ph_lo = ph; a.ph_hi = ph + 1;
        hipLaunchKernelGGL(mega, dim3(grid), dim3(512), LDS_BYTES, stream, a);
    }
#ifdef MK_DUMP
    { const unsigned short* pa = (const unsigned short*)((unsigned char*)d_ws + MK_DUMP_A); const unsigned short* pb = MK_DUMP_B ? (const unsigned short*)((unsigned char*)d_ws + MK_DUMP_B) : nullptr;
      hipLaunchKernelGGL(dump_k, dim3(2048), dim3(256), 0, stream, pa, pb, (float*)d_out, (size_t)MK_DUMP_N); }
#endif
#endif
}
```
